# Optimizing an MI355X kernel written in HIP

```python
import math
import jax, jax.numpy as jnp
from jax import lax
import numpy as np


D_MODEL = 1024
BATCH = 8
SEQ = 2048
DEPTH = 2
DEC_BATCH = 128
DEC_SEQ = 1
PAST_LEN = 16384
PAGE_SIZE = 128

MIX_WIDTH = D_MODEL
W_A = MIX_WIDTH // 4
W_B = MIX_WIDTH // 4
W_C = MIX_WIDTH // 4
W_D = MIX_WIDTH - W_A - W_B - W_C
A_HEADS = 4
A_HEAD_DIM = W_A // A_HEADS
CHUNK = 128
POOL_WINDOWS = (2, 4, 8, 16)
POOL_GROUP = W_B // len(POOL_WINDOWS)
POOL_BUF = max(POOL_WINDOWS) - 1
CONV_W = 3
D_HEAD_DIM = 64
D_HEADS = W_D // D_HEAD_DIM
R_DECAY = 32
R_AAA = 32
R_GATE = 64
D_PROJ = 3 * W_D + R_DECAY + R_AAA + R_GATE
PROJ = 2 * W_A + W_B + 3 * W_C + D_PROJ
MEM_LEN = 256
X_HEADS = 4
X_HEAD_DIM = D_MODEL // X_HEADS
D_FF = int(math.ceil(8 * D_MODEL / 3 / 256)) * 256
ALPHA = (2 * DEPTH) ** 0.25
BETA = (8 * DEPTH) ** -0.25
LN_EPS = 1e-5
GN_EPS = 64e-5

kernel_name = 'hymba_style_chunkmlp_pool_conv_rwkv7_decoder_step'


def layer_norm(x, g, b, eps=LN_EPS):
    xf = x.astype(jnp.float32)
    mu = jnp.mean(xf, axis=-1, keepdims=True)
    var = jnp.mean(jnp.square(xf - mu), axis=-1, keepdims=True)
    return ((xf - mu) * lax.rsqrt(var + eps)).astype(x.dtype) * g + b


def chunk_spatial_gate(v, ws, bs):
    bn, t, _ = v.shape
    n_chunks = -(-t // CHUNK)
    vp = jnp.pad(v, ((0, 0), (0, n_chunks * CHUNK - t), (0, 0)))
    vp = vp.reshape(bn, n_chunks, CHUNK, A_HEADS, A_HEAD_DIM)
    ws_causal = ws * jnp.tril(jnp.ones((CHUNK, CHUNK), ws.dtype))
    z = jnp.einsum('hts,bcshd->bcthd', ws_causal, vp) + jnp.swapaxes(bs, 0, 1)[None, None, :, :, None]
    return z.reshape(bn, n_chunks * CHUNK, W_A)[:, :t]


def multiscale_pool(xb, buf, pos0, w_pool, scale):
    t = xb.shape[1]
    x_ext = jnp.concatenate([buf, xb], axis=1)
    cs = jnp.cumsum(x_ext.astype(jnp.float32), axis=1)
    cs = jnp.pad(cs, ((0, 0), (1, 0), (0, 0)))
    end = cs[:, POOL_BUF + 1:]
    pos = pos0 + jnp.arange(t)
    outs = []
    for gi, win in enumerate(POOL_WINDOWS):
        sl = slice(gi * POOL_GROUP, (gi + 1) * POOL_GROUP)
        start = cs[:, POOL_BUF + 1 - win:POOL_BUF + 1 - win + t, sl]
        cnt = jnp.minimum(win, pos + 1).astype(jnp.float32)[None, :, None]
        d = ((end[..., sl] - start) / cnt).astype(xb.dtype) - xb[..., sl]
        outs.append(d @ w_pool[gi])
    y = jnp.concatenate(outs, axis=-1) * scale
    return y, x_ext[:, -POOL_BUF:]


def short_conv(xc, buf, conv_w):
    bg, cg, xin = jnp.split(xc, 3, axis=-1)
    z = cg * xin
    t = z.shape[1]
    z_ext = jnp.concatenate([buf, z], axis=1)
    y = conv_w[0] * z_ext[:, 0:t]
    for j in range(1, CONV_W):
        y = y + conv_w[j] * z_ext[:, j:j + t]
    return bg * y, z_ext[:, -(CONV_W - 1):]


def wkv_scan(s0, r, w, k, v, kk, a):
    def step(s, inp):
        r_t, w_t, k_t, v_t, kk_t, a_t = inp
        sa = jnp.einsum('bhvk,bhk->bhv', s, -kk_t)
        s = s * w_t[:, :, None, :] + sa[..., None] * (kk_t * a_t)[:, :, None, :] + v_t[..., None] * k_t[:, :, None, :]
        return s, jnp.einsum('bhvk,bhk->bhv', s, r_t)
    tm = lambda z: jnp.swapaxes(z, 0, 1)
    s, o = lax.scan(step, s0, (tm(r), tm(w), tm(k), tm(v), tm(kk), tm(a)))
    return tm(o), s


def rwkv7_mix(pd, shift_buf, s0, p):
    bn, t, _ = pd.shape
    prev = jnp.concatenate([shift_buf, pd[:, :-1]], axis=1)
    xs = pd + (prev - pd) * p['mu_d']
    r, k, v, dw, da, dg = jnp.split(xs, (W_D, 2 * W_D, 3 * W_D, 3 * W_D + R_DECAY, 3 * W_D + R_DECAY + R_AAA), axis=-1)
    w_log = -jax.nn.softplus(-(p['rwkv_w0'] + jnp.tanh(dw) @ p['rwkv_w2']).astype(jnp.float32)) - 0.5
    decay = jnp.exp(-jnp.exp(w_log))
    a = jax.nn.sigmoid(p['rwkv_a0'] + da @ p['rwkv_a2'])
    g = jax.nn.sigmoid(dg) @ p['rwkv_g2']
    heads = lambda z: z.reshape(bn, t, D_HEADS, D_HEAD_DIM).astype(jnp.float32)
    kk = heads(k * p['rwkv_k_k'])
    kk = kk * lax.rsqrt(jnp.maximum(jnp.sum(kk * kk, axis=-1, keepdims=True), 1e-12))
    k = k * (1 + (a - 1) * p['rwkv_k_a'])
    rh, kh, vh, ah, wh = heads(r), heads(k), heads(v), heads(a), heads(decay)
    o, s = wkv_scan(s0.astype(jnp.float32), rh, wh, kh, vh, kk, ah)
    mu = jnp.mean(o, axis=-1, keepdims=True)
    var = jnp.mean(jnp.square(o - mu), axis=-1, keepdims=True)
    o = ((o - mu) * lax.rsqrt(var + GN_EPS)).reshape(bn, t, W_D) * p['rwkv_lnx_g'] + p['rwkv_lnx_b']
    bonus = jnp.sum(rh * kh * p['rwkv_r_k'], axis=-1, keepdims=True) * vh
    o = (o + bonus.reshape(bn, t, W_D)) * g
    return o.astype(pd.dtype), pd[:, -1:], s


def hybrid_mixer(h, pos0, pool_buf, conv_buf, shift_buf, wkv_state, p):
    proj = h @ p['w_in']
    pa, pb, pc, pd = jnp.split(proj, (2 * W_A, 2 * W_A + W_B, 2 * W_A + W_B + 3 * W_C), axis=-1)
    u, v = jnp.split(jax.nn.gelu(pa), 2, axis=-1)
    v = layer_norm(v, p['ln_v_g'], p['ln_v_b'])
    ya = u * chunk_spatial_gate(v, p['ws_chunk'], p['b_chunk'])
    yb, pool_buf = multiscale_pool(pb, pool_buf, pos0, p['w_pool'], p['pool_scale'])
    yc, conv_buf = short_conv(pc, conv_buf, p['conv_w'])
    yd, shift_buf, wkv_state = rwkv7_mix(pd, shift_buf, wkv_state, p)
    y = jnp.concatenate([ya, yb, yc, yd], axis=-1) @ p['w_out']
    return y, v, pool_buf, conv_buf, shift_buf, wkv_state


def cross_attention(h, mk, mv, wq, wo):
    bn, t, _ = h.shape
    q = (h @ wq).reshape(bn, t, X_HEADS, X_HEAD_DIM)
    s = jnp.einsum('bthd,bmhd->bhtm', q, mk).astype(jnp.float32) * (X_HEAD_DIM ** -0.5)
    pr = jax.nn.softmax(s, axis=-1).astype(h.dtype)
    o = jnp.einsum('bhtm,bmhd->bthd', pr, mv).reshape(bn, t, X_HEADS * X_HEAD_DIM)
    return o @ wo


def swiglu(h, w1, w3, w2):
    return (jax.nn.silu(h @ w1) * (h @ w3)) @ w2


def decoder_layer(h, pos0, mem_k, mem_v, pool_buf, conv_buf, shift_buf, wkv_state, p):
    y, v_rows, pool_buf, conv_buf, shift_buf, wkv_state = hybrid_mixer(h, pos0, pool_buf, conv_buf, shift_buf, wkv_state, p)
    h = layer_norm(ALPHA * h + y, p['ln1_g'], p['ln1_b'])
    h = layer_norm(ALPHA * h + cross_attention(h, mem_k, mem_v, p['w_xq'], p['w_xo']), p['ln2_g'], p['ln2_b'])
    h = layer_norm(ALPHA * h + swiglu(h, p['ffn_w1'], p['ffn_w3'], p['ffn_w2']), p['ln3_g'], p['ln3_b'])
    return h, v_rows, pool_buf, conv_buf, shift_buf, wkv_state


def setup_inputs(seed: int = 0) -> dict:
    key = jax.random.key(seed)
    ks = iter(jax.random.split(key, 64))
    f32 = jnp.float32
    L = DEPTH
    nrm = lambda shape, scale: jax.random.normal(next(ks), shape, f32) * scale
    gain = lambda shape: 1.0 + 0.05 * jax.random.normal(next(ks), shape, f32)
    return {
        'x_prompt': nrm((BATCH, SEQ, D_MODEL), 1.0),
        'x_sample': nrm((DEC_BATCH, DEC_SEQ, D_MODEL), 1.0),
        'mem_prompt': nrm((BATCH, MEM_LEN, D_MODEL), 1.0),
        'cache_mem_k': nrm((L, DEC_BATCH, MEM_LEN, X_HEADS, X_HEAD_DIM), 1.0),
        'cache_mem_v': nrm((L, DEC_BATCH, MEM_LEN, X_HEADS, X_HEAD_DIM), 1.0),
        'state_pool': nrm((L, DEC_BATCH, POOL_BUF, W_B), 1.0),
        'state_conv': nrm((L, DEC_BATCH, CONV_W - 1, W_C), 1.0),
        'state_shift': nrm((L, DEC_BATCH, 1, D_PROJ), 1.0),
        'state_wkv': nrm((L, DEC_BATCH, D_HEADS, D_HEAD_DIM, D_HEAD_DIM), 0.3),
        'w_in': nrm((L, D_MODEL, PROJ), D_MODEL ** -0.5),
        'mu_d': jax.random.uniform(next(ks), (L, D_PROJ), f32),
        'ln_v_g': gain((L, W_A)),
        'ln_v_b': nrm((L, W_A), 0.02),
        'ws_chunk': nrm((L, A_HEADS, CHUNK, CHUNK), CHUNK ** -0.5),
        'b_chunk': gain((L, A_HEADS, CHUNK)),
        'w_pool': nrm((L, len(POOL_WINDOWS), POOL_GROUP, POOL_GROUP), POOL_GROUP ** -0.5),
        'pool_scale': gain((L, W_B)),
        'conv_w': nrm((L, CONV_W, W_C), 0.5),
        'rwkv_w0': jax.random.uniform(next(ks), (L, W_D), f32, -6.0, 0.5),
        'rwkv_w2': nrm((L, R_DECAY, W_D), 0.1),
        'rwkv_a0': nrm((L, W_D), 0.1),
        'rwkv_a2': nrm((L, R_AAA, W_D), 0.1),
        'rwkv_g2': nrm((L, R_GATE, W_D), R_GATE ** -0.5),
        'rwkv_k_k': 0.85 + 0.05 * jax.random.normal(next(ks), (L, W_D), f32),
        'rwkv_k_a': gain((L, W_D)),
        'rwkv_r_k': nrm((L, D_HEADS, D_HEAD_DIM), 0.1),
        'rwkv_lnx_g': gain((L, W_D)),
        'rwkv_lnx_b': nrm((L, W_D), 0.02),
        'w_out': nrm((L, MIX_WIDTH, D_MODEL), MIX_WIDTH ** -0.5 * BETA),
        'ln1_g': gain((L, D_MODEL)),
        'ln1_b': nrm((L, D_MODEL), 0.02),
        'w_xq': nrm((L, D_MODEL, X_HEADS * X_HEAD_DIM), D_MODEL ** -0.5),
        'w_xk': nrm((L, D_MODEL, X_HEADS * X_HEAD_DIM), D_MODEL ** -0.5),
        'w_xv': nrm((L, D_MODEL, X_HEADS * X_HEAD_DIM), D_MODEL ** -0.5),
        'w_xo': nrm((L, X_HEADS * X_HEAD_DIM, D_MODEL), (X_HEADS * X_HEAD_DIM) ** -0.5 * BETA),
        'ln2_g': gain((L, D_MODEL)),
        'ln2_b': nrm((L, D_MODEL), 0.02),
        'ffn_w1': nrm((L, D_MODEL, D_FF), D_MODEL ** -0.5),
        'ffn_w3': nrm((L, D_MODEL, D_FF), D_MODEL ** -0.5),
        'ffn_w2': nrm((L, D_FF, D_MODEL), D_FF ** -0.5 * BETA),
        'ln3_g': gain((L, D_MODEL)),
        'ln3_b': nrm((L, D_MODEL), 0.02),
    }


def reference(x_prompt, x_sample, mem_prompt, cache_mem_k, cache_mem_v, state_pool, state_conv, state_shift, state_wkv,
              w_in, mu_d, ln_v_g, ln_v_b, ws_chunk, b_chunk, w_pool, pool_scale, conv_w,
              rwkv_w0, rwkv_w2, rwkv_a0, rwkv_a2, rwkv_g2, rwkv_k_k, rwkv_k_a, rwkv_r_k, rwkv_lnx_g, rwkv_lnx_b,
              w_out, ln1_g, ln1_b, w_xq, w_xk, w_xv, w_xo, ln2_g, ln2_b, ffn_w1, ffn_w3, ffn_w2, ln3_g, ln3_b):
    bp, t_p, _ = x_prompt.shape
    last_chunk_start = ((t_p - 1) // CHUNK) * CHUNK
    dt = x_prompt.dtype
    hp, hs = x_prompt, x_sample
    pv, ppool, pconv, pshift, pwkv, pmk, pmv = [], [], [], [], [], [], []
    sv, spool, sconv, sshift, swkv = [], [], [], [], []
    for l in range(DEPTH):
        p = dict(w_in=w_in[l], mu_d=mu_d[l], ln_v_g=ln_v_g[l], ln_v_b=ln_v_b[l], ws_chunk=ws_chunk[l],
                 b_chunk=b_chunk[l], w_pool=w_pool[l], pool_scale=pool_scale[l], conv_w=conv_w[l],
                 rwkv_w0=rwkv_w0[l], rwkv_w2=rwkv_w2[l], rwkv_a0=rwkv_a0[l], rwkv_a2=rwkv_a2[l],
                 rwkv_g2=rwkv_g2[l], rwkv_k_k=rwkv_k_k[l], rwkv_k_a=rwkv_k_a[l], rwkv_r_k=rwkv_r_k[l],
                 rwkv_lnx_g=rwkv_lnx_g[l], rwkv_lnx_b=rwkv_lnx_b[l], w_out=w_out[l],
                 ln1_g=ln1_g[l], ln1_b=ln1_b[l], w_xq=w_xq[l], w_xo=w_xo[l], ln2_g=ln2_g[l], ln2_b=ln2_b[l],
                 ffn_w1=ffn_w1[l], ffn_w3=ffn_w3[l], ffn_w2=ffn_w2[l], ln3_g=ln3_g[l], ln3_b=ln3_b[l])
        mk_p = (mem_prompt @ w_xk[l]).reshape(bp, MEM_LEN, X_HEADS, X_HEAD_DIM)
        mv_p = (mem_prompt @ w_xv[l]).reshape(bp, MEM_LEN, X_HEADS, X_HEAD_DIM)
        hp, v_rows, pb, cb, sb, wk = decoder_layer(
            hp, 0, mk_p, mv_p,
            jnp.zeros((bp, POOL_BUF, W_B), dt), jnp.zeros((bp, CONV_W - 1, W_C), dt),
            jnp.zeros((bp, 1, D_PROJ), dt), jnp.zeros((bp, D_HEADS, D_HEAD_DIM, D_HEAD_DIM), jnp.float32), p)
        pv.append(v_rows[:, last_chunk_start:])
        ppool.append(pb)
        pconv.append(cb)
        pshift.append(sb)
        pwkv.append(wk)
        pmk.append(mk_p)
        pmv.append(mv_p)
        hs, v_rows_s, pb_s, cb_s, sb_s, wk_s = decoder_layer(
            hs, PAST_LEN, cache_mem_k[l], cache_mem_v[l],
            state_pool[l], state_conv[l], state_shift[l], state_wkv[l], p)
        sv.append(v_rows_s)
        spool.append(pb_s)
        sconv.append(cb_s)
        sshift.append(sb_s)
        swkv.append(wk_s)
    return (hp, hs,
            jnp.stack(pv), jnp.stack(ppool), jnp.stack(pconv), jnp.stack(pshift), jnp.stack(pwkv),
            jnp.stack(pmk), jnp.stack(pmv),
            jnp.stack(sv), jnp.stack(spool), jnp.stack(sconv), jnp.stack(sshift), jnp.stack(swkv))
```

```cpp
#include <hip/hip_runtime.h>
#include <hip/hip_cooperative_groups.h>
#include <cstdio>
namespace cg = cooperative_groups;

typedef unsigned short u16;
typedef __attribute__((ext_vector_type(8))) short bf16x8;
typedef __attribute__((ext_vector_type(4))) float f32x4;
typedef __attribute__((ext_vector_type(4))) unsigned u32x4;
#define DEV __device__ __forceinline__

constexpr int TP = 16384, TS = 128, TT = 16512, DM = 1024, PRJ = 2432, DFF = 2816;
constexpr float ALPHA = 1.41421356237309515f;
#define XB_CUTAB 3456
#define XB_JOBCTR(l) (3456 + 4096 + 64 * (l))
#define XB_TOTAL_WORDS (3456 + 4096 + 128)
constexpr size_t O_YP = 0;
constexpr size_t O_YS = O_YP + (size_t)TP * DM;
constexpr size_t O_CVP = O_YS + (size_t)TS * DM;
constexpr size_t O_PLP = O_CVP + 2 * 8 * 128 * 256;
constexpr size_t O_CNP = O_PLP + 2 * 8 * 15 * 256;
constexpr size_t O_SHP = O_CNP + 2 * 8 * 2 * 256;
constexpr size_t O_WKP = O_SHP + 2 * 8 * 896;
constexpr size_t O_MKP = O_WKP + 2 * 8 * 4 * 64 * 64;
constexpr size_t O_MVP = O_MKP + 2 * 8 * 256 * 1024;
constexpr size_t O_CVS = O_MVP + 2 * 8 * 256 * 1024;
constexpr size_t O_PLS = O_CVS + 2 * 128 * 256;
constexpr size_t O_CNS = O_PLS + 2 * 128 * 15 * 256;
constexpr size_t O_SHS = O_CNS + 2 * 128 * 2 * 256;
constexpr size_t O_WKS = O_SHS + 2 * 128 * 896;


constexpr size_t WO_IN = 0;
constexpr size_t WO_OUT = WO_IN + (size_t)PRJ * DM;
constexpr size_t WO_XQ = WO_OUT + (size_t)DM * DM;
constexpr size_t WO_XK = WO_XQ + (size_t)DM * DM;
constexpr size_t WO_XV = WO_XK + (size_t)DM * DM;
constexpr size_t WO_XO = WO_XV + (size_t)DM * DM;
constexpr size_t WO_13 = WO_XO + (size_t)DM * DM;
constexpr size_t WO_2 = WO_13 + (size_t)2 * DFF * DM;
constexpr size_t W_LAYER = WO_2 + (size_t)DM * DFF;

enum { I_XP = 0, I_XS, I_MEM, I_CK, I_CV, I_SPOOL, I_SCONV, I_SSHIFT, I_SWKV, I_WIN, I_MUD, I_LNVG, I_LNVB, I_WSC, I_BCH,
       I_WPOOL, I_PSCALE, I_CONVW, I_W0, I_W2, I_A0, I_A2, I_G2, I_KK, I_KA, I_RK, I_LNXG, I_LNXB, I_WOUT, I_LN1G, I_LN1B,
       I_WXQ, I_WXK, I_WXV, I_WXO, I_LN2G, I_LN2B, I_FW1, I_FW3, I_FW2, I_LN3G, I_LN3B };

struct Params {
  const float* in[42];
  float* out;
  u16* wt;
  u16* xb; float* hf; float* proj; u16* mix; float* pre; u16* qb; u16* ao; u16* ffh;
  float* scanin; float* obuf; float* gbuf; u16* memb; u16* kb; u16* vtb;
  unsigned* bar;
};

DEV int tidx() { int t = (int)__builtin_amdgcn_workitem_id_x(); asm volatile("" : "+v"(t)); return t; }
DEV u16 f2bf(float f) {
  unsigned u = __float_as_uint(f);
  u += 0x7fffu + ((u >> 16) & 1u);
  return (u16)(u >> 16);
}
DEV unsigned pack2(float a, float b) { return (unsigned)f2bf(a) | ((unsigned)f2bf(b) << 16); }
DEV float bf2f(u16 h) { return __uint_as_float(((unsigned)h) << 16); }
DEV float frcp(float x) { return __builtin_amdgcn_rcpf(x); }
DEV float ftanh(float x) {
  float e = __expf(2.f * fminf(fmaxf(x, -15.f), 15.f));
  return (e - 1.f) * frcp(e + 1.f);
}
DEV float gelu_t(float x) { return 0.5f * x * (1.f + ftanh(0.7978845608028654f * (x + 0.044715f * x * x * x))); }
DEV float sigm(float x) { return frcp(1.f + __expf(-x)); }
DEV float softplus(float x) { return fmaxf(x, 0.f) + __logf(1.f + __expf(-fabsf(x))); }

template <int CTRL> DEV float dpp_mov(float x) {
  return __int_as_float(__builtin_amdgcn_update_dpp(0, __float_as_int(x), CTRL, 0xf, 0xf, false));
}
DEV float row16_sum(float x) {
  x += dpp_mov<0xB1>(x);
  x += dpp_mov<0x4E>(x);
  x += dpp_mov<0x141>(x);
  x += dpp_mov<0x140>(x);
  return x;
}
DEV float wave_sum(float x) {
  x = row16_sum(x);
  x += __shfl_xor(x, 16);
  x += __shfl_xor(x, 32);
  return x;
}

enum { EP_PROJ = 0, EP_RES, EP_Q, EP_FFN1, EP_MEMK, EP_MEMV };

template <int NJ>
DEV void gemm_tile(const Params& P, int mode, int l, const u16* __restrict__ A, int lda, const u16* __restrict__ Bt, int ldb,
                   int K, int row0, int col0, char* smem) {
  u16* sA0 = (u16*)smem;
  u16* sB0 = (u16*)(smem + 16384);
  u16* sA1 = (u16*)(smem + 32768);
  u16* sB1 = (u16*)(smem + 49152);
  const int tid = tidx(), lane = tid & 63, wave = tid >> 6;
  const int wm = wave >> 1, wn = wave & 1;
  const int fr = lane & 15, fq = lane >> 4;
  const int lr = tid >> 3, ls = tid & 7;
  const u16* Ag = A + (size_t)(row0 + lr) * lda + ls * 8;
  const u16* Bg = Bt + (size_t)(col0 + lr) * ldb + ls * 8;
  const int woff = lr * 64 + ((ls ^ (lr & 7)) * 8);
  f32x4 acc[4][4];
#pragma unroll
  for (int i = 0; i < 4; i++)
#pragma unroll
    for (int j = 0; j < 4; j++) acc[i][j] = (f32x4){0.f, 0.f, 0.f, 0.f};
  u32x4 ga0[4], gb0[4], ga1[4], gb1[4];
#define G_LOAD(RA, RB, KT)                                                      \
  _Pragma("unroll") for (int i = 0; i < 4; i++) {                               \
    RA[i] = *(const u32x4*)(Ag + (size_t)(i * 32) * lda + (KT) * 64);           \
    if (i < NJ) RB[i] = *(const u32x4*)(Bg + (size_t)(i * 32) * ldb + (KT) * 64); \
  }
#define L_STORE(SA, SB, RA, RB)                                                 \
  _Pragma("unroll") for (int i = 0; i < 4; i++) {                               \
    *(u32x4*)(SA + woff + i * 2048) = RA[i];                                    \
    if (i < NJ) *(u32x4*)(SB + woff + i * 2048) = RB[i];                        \
  }
#define G_READ(SA, SB)                                                          \
  _Pragma("unroll") for (int ks = 0; ks < 2; ks++) {                            \
    const int slot = ks * 4 + fq;                                               \
    {                                                                           \
      int row = wm * 64 + fr;                                                   \
      af[ks][0] = *(const bf16x8*)(SA + row * 64 + ((slot ^ (row & 7)) * 8));   \
    }                                                                           \
    _Pragma("unroll") for (int j = 0; j < NJ; j++) {                            \
      int row = wn * (NJ * 16) + j * 16 + fr;                                   \
      bfr[ks][j] = *(const bf16x8*)(SB + row * 64 + ((slot ^ (row & 7)) * 8));  \
    }                                                                           \
    _Pragma("unroll") for (int i = 1; i < 4; i++) {                             \
      int row = wm * 64 + i * 16 + fr;                                          \
      af[ks][i] = *(const bf16x8*)(SA + row * 64 + ((slot ^ (row & 7)) * 8));   \
    }                                                                           \
  }
#define G_MMA                                                                   \
  _Pragma("unroll") for (int ks = 0; ks < 2; ks++)                              \
    _Pragma("unroll") for (int i = 0; i < 4; i++)                               \
      _Pragma("unroll") for (int j = 0; j < NJ; j++)                            \
        acc[i][j] = __builtin_amdgcn_mfma_f32_16x16x32_bf16(af[ks][i], bfr[ks][j], acc[i][j], 0, 0, 0);
#define G_SCHED                                                                 \
  if (NJ == 4) {                                                                \
    __builtin_amdgcn_sched_group_barrier(0x100, 2, 0);                          \
    _Pragma("unroll") for (int q_ = 0; q_ < 14; q_++) {                         \
      __builtin_amdgcn_sched_group_barrier(0x008, 1, 0);                        \
      __builtin_amdgcn_sched_group_barrier(0x100, 1, 0);                        \
    }                                                                           \
    __builtin_amdgcn_sched_group_barrier(0x008, 2, 0);                          \
    _Pragma("unroll") for (int q_ = 0; q_ < 8; q_++) {                          \
      __builtin_amdgcn_sched_group_barrier(0x008, 2, 0);                        \
      __builtin_amdgcn_sched_group_barrier(0x200, 1, 0);                        \
      __builtin_amdgcn_sched_group_barrier(0x020, 1, 0);                        \
    }                                                                           \
  }
  bf16x8 af[2][4], bfr[2][4];
  const int nk = K >> 6;
  __syncthreads();
  G_LOAD(ga0, gb0, 0)
  G_LOAD(ga1, gb1, 1)
  L_STORE(sA0, sB0, ga0, gb0)
  G_LOAD(ga0, gb0, 2)
  __syncthreads();
  for (int kt = 0; kt < nk; kt += 2) {
    G_READ(sA0, sB0)
    L_STORE(sA1, sB1, ga1, gb1)
    { const int k3 = min(kt + 3, nk - 1); G_LOAD(ga1, gb1, k3) }
    G_MMA
    G_SCHED
    __syncthreads();
    G_READ(sA1, sB1)
    L_STORE(sA0, sB0, ga0, gb0)
    { const int k4 = min(kt + 4, nk - 1); G_LOAD(ga0, gb0, k4) }
    G_MMA
    G_SCHED
    __syncthreads();
  }
#undef G_LOAD
#undef L_STORE
#undef G_READ
#undef G_MMA
#undef G_SCHED
  const int rb0 = row0 + wm * 64 + fq * 4;
  const int cb0 = col0 + wn * (NJ * 16) + fr;
  if (NJ == 4 && mode == EP_PROJ) {
#pragma unroll
    for (int i = 0; i < 4; i++)
#pragma unroll
      for (int e = 0; e < 4; e++) {
        int row = rb0 + i * 16 + e;
#pragma unroll
        for (int j = 0; j < 4; j++) {
          int col = cb0 + j * 16;
          float v = acc[i][j][e];
          if (col < 512) v = gelu_t(v);
          P.proj[(size_t)row * PRJ + col] = v;
        }
      }
  } else if (mode == EP_RES) {
    float hv[4][4][4];
#pragma unroll
    for (int i = 0; i < 4; i++)
#pragma unroll
      for (int e = 0; e < 4; e++)
#pragma unroll
        for (int j = 0; j < NJ; j++) hv[i][e][j] = P.hf[(size_t)(rb0 + i * 16 + e) * DM + cb0 + j * 16];
#pragma unroll
    for (int i = 0; i < 4; i++)
#pragma unroll
      for (int e = 0; e < 4; e++)
#pragma unroll
        for (int j = 0; j < NJ; j++) P.pre[(size_t)(rb0 + i * 16 + e) * DM + cb0 + j * 16] = ALPHA * hv[i][e][j] + acc[i][j][e];
  } else if (mode == EP_Q) {
#pragma unroll
    for (int i = 0; i < 4; i++)
#pragma unroll
      for (int e = 0; e < 4; e++) {
        int row = rb0 + i * 16 + e;
#pragma unroll
        for (int j = 0; j < NJ; j++) {
          int col = cb0 + j * 16;
          P.qb[(size_t)row * DM + col] = f2bf(acc[i][j][e] * 0.0625f);
        }
      }
  } else if (NJ == 4 && mode == EP_FFN1) {
    const int oc0 = ((col0 + wn * 64) >> 1) + fr;
#pragma unroll
    for (int i = 0; i < 4; i++)
#pragma unroll
      for (int e = 0; e < 4; e++) {
        int row = rb0 + i * 16 + e;
#pragma unroll
        for (int j = 0; j < 2; j++) {
          float a = acc[i][j][e], b = acc[i][j + 2][e];
          float v = a * sigm(a) * b;
          P.ffh[(size_t)row * DFF + oc0 + j * 16] = f2bf(v);
        }
      }
  } else if (NJ == 4 && mode == EP_MEMK) {
    float* ok = P.out + O_MKP + (size_t)l * 2048 * 1024;
    u16* kb = P.kb + (size_t)l * 2048 * 1024;
#pragma unroll
    for (int i = 0; i < 4; i++)
#pragma unroll
      for (int e = 0; e < 4; e++) {
        int row = rb0 + i * 16 + e;
#pragma unroll
        for (int j = 0; j < 4; j++) {
          int col = cb0 + j * 16;
          float v = acc[i][j][e];
          ok[(size_t)row * DM + col] = v;
          kb[(size_t)row * DM + col] = f2bf(v);
        }
      }
  } else if (NJ == 4) {
    float* ov = P.out + O_MVP + (size_t)l * 2048 * 1024;
#pragma unroll
    for (int i = 0; i < 4; i++) {
      int row = rb0 + i * 16;
      int b = row >> 8, m = row & 255;
#pragma unroll
      for (int j = 0; j < 4; j++) {
        int col = cb0 + j * 16;
#pragma unroll
        for (int e = 0; e < 4; e++) ov[(size_t)(row + e) * DM + col] = acc[i][j][e];
        uint2 pk;
        pk.x = pack2(acc[i][j][0], acc[i][j][1]);
        pk.y = pack2(acc[i][j][2], acc[i][j][3]);
        *(uint2*)(P.vtb + ((size_t)(l * 8 + b) * 1024 + col) * 256 + m) = pk;
      }
    }
  }
}

DEV void tile_map(int t, int mtiles, int ntiles, int& mt, int& nt) {
  const int g = t / (8 * ntiles);
  int r = t - g * 8 * ntiles;
  const int rows = min(8, mtiles - 8 * g);
  int p = 0;
  if (rows == 8) { p = r >> 6; r -= p << 6; }
  else { const int per = rows * 8; p = r / per; r -= p * per; }
  const int pc = min(8, ntiles - 8 * p);
  (void)pc;
  const int ml = r % rows, nl = r / rows;
  mt = 8 * g + ml;
  nt = 8 * p + nl;
}

DEV void gemm_phase(const Params& P, int mode, int l, const u16* A, int lda, const u16* Bt, int ldb, int K, int mtiles, int ntiles,
                    char* smem, int split = 0) {
  const int mm = split ? mtiles - 1 : mtiles;
  const int total = mm * ntiles;
  const int nb = gridDim.x;
  if ((nb & 7) == 0) {
    const int x = blockIdx.x & 7, bl = blockIdx.x >> 3, per = nb >> 3;
    const int Q = (total + 7) >> 3;
    for (int li = bl; li < Q; li += per) {
      int t = x * Q + li;
      if (t >= total) break;
      int mt, nt;
      tile_map(t, mm, ntiles, mt, nt);
      gemm_tile<4>(P, mode, l, A, lda, Bt, ldb, K, mt * 128, nt * 128, smem);
    }
  } else {
    for (int t = blockIdx.x; t < total; t += nb) {
      int mt, nt;
      tile_map(t, mm, ntiles, mt, nt);
      gemm_tile<4>(P, mode, l, A, lda, Bt, ldb, K, mt * 128, nt * 128, smem);
    }
  }
  if (split) {
    const int vbk = (nb & 7) == 0 ? ((blockIdx.x >> 3) * 8 + (blockIdx.x & 7)) : blockIdx.x;
    for (int ht = vbk; ht < 2 * ntiles; ht += nb) gemm_tile<2>(P, mode, l, A, lda, Bt, ldb, K, mm * 128, ht * 64, smem);
  }
}

DEV void transpose_tile(const float* __restrict__ src, int K, int N, u16* __restrict__ dst, int mode, int kt, int nt, float* sT) {
  const int tid = tidx();
  const int r = tid >> 4, c4 = (tid & 15) * 4;
#pragma unroll
  for (int i = 0; i < 4; i++) {
    int rr = r + 16 * i;
    float4 v = *(const float4*)(src + (size_t)(kt * 64 + rr) * N + nt * 64 + c4);
    sT[rr * 65 + c4 + 0] = v.x;
    sT[rr * 65 + c4 + 1] = v.y;
    sT[rr * 65 + c4 + 2] = v.z;
    sT[rr * 65 + c4 + 3] = v.w;
  }
  __syncthreads();
  const int n = tid >> 2, kseg = (tid & 3) * 16;
  unsigned pk[8];
#pragma unroll
  for (int j = 0; j < 8; j++) pk[j] = pack2(sT[(kseg + 2 * j) * 65 + n], sT[(kseg + 2 * j + 1) * 65 + n]);
  const int ncol = nt * 64 + n;
  const int drow = (mode == 0) ? ncol : ((ncol >> 5) * 64 + (mode == 2 ? 32 : 0) + (ncol & 31));
  u16* d = dst + (size_t)drow * K + kt * 64 + kseg;
  *(uint4*)(d) = make_uint4(pk[0], pk[1], pk[2], pk[3]);
  *(uint4*)(d + 8) = make_uint4(pk[4], pk[5], pk[6], pk[7]);
  __syncthreads();
}

DEV void phase_prep(const Params& P, char* smem) {
  float* sT = (float*)smem;
  for (int it = blockIdx.x; it < 8000; it += gridDim.x) {
    int l = it / 4000, r = it - l * 4000;
    const float* src; u16* dst; int K, N, mode = 0, idx;
    if (r < 608) { idx = r; src = P.in[I_WIN] + (size_t)l * 1024 * 2432; dst = P.wt + l * W_LAYER + WO_IN; K = 1024; N = 2432; }
    else if (r < 864) { idx = r - 608; src = P.in[I_WOUT] + (size_t)l * 1048576; dst = P.wt + l * W_LAYER + WO_OUT; K = 1024; N = 1024; }
    else if (r < 1120) { idx = r - 864; src = P.in[I_WXQ] + (size_t)l * 1048576; dst = P.wt + l * W_LAYER + WO_XQ; K = 1024; N = 1024; }
    else if (r < 1376) { idx = r - 1120; src = P.in[I_WXK] + (size_t)l * 1048576; dst = P.wt + l * W_LAYER + WO_XK; K = 1024; N = 1024; }
    else if (r < 1632) { idx = r - 1376; src = P.in[I_WXV] + (size_t)l * 1048576; dst = P.wt + l * W_LAYER + WO_XV; K = 1024; N = 1024; }
    else if (r < 1888) { idx = r - 1632; src = P.in[I_WXO] + (size_t)l * 1048576; dst = P.wt + l * W_LAYER + WO_XO; K = 1024; N = 1024; }
    else if (r < 2592) { idx = r - 1888; src = P.in[I_FW1] + (size_t)l * 1024 * 2816; dst = P.wt + l * W_LAYER + WO_13; K = 1024; N = 2816; mode = 1; }
    else if (r < 3296) { idx = r - 2592; src = P.in[I_FW3] + (size_t)l * 1024 * 2816; dst = P.wt + l * W_LAYER + WO_13; K = 1024; N = 2816; mode = 2; }
    else { idx = r - 3296; src = P.in[I_FW2] + (size_t)l * 2816 * 1024; dst = P.wt + l * W_LAYER + WO_2; K = 2816; N = 1024; }
    int ntn = N >> 6;
    int kt = idx / ntn, nt = idx - kt * ntn;
    transpose_tile(src, K, N, dst, mode, kt, nt, sT);
  }
  const size_t gt = (size_t)blockIdx.x * blockDim.x + tidx(), gs = (size_t)gridDim.x * blockDim.x;
  {
    const size_t n4 = (size_t)TT * DM / 4, np4 = (size_t)TP * DM / 4;
    for (size_t i0 = gt; i0 < n4; i0 += 4 * gs) {
      float4 v[4];
#pragma unroll
      for (int u = 0; u < 4; u++) {
        size_t i = i0 + u * gs;
        if (i >= n4) i = i0;
        v[u] = (i < np4) ? ((const float4*)P.in[I_XP])[i] : ((const float4*)P.in[I_XS])[i - np4];
      }
#pragma unroll
      for (int u = 0; u < 4; u++) {
        size_t i = i0 + u * gs;
        if (i < n4) {
          ((float4*)P.hf)[i] = v[u];
          ((uint2*)P.xb)[i] = make_uint2(pack2(v[u].x, v[u].y), pack2(v[u].z, v[u].w));
        }
      }
    }
    const size_t m4 = (size_t)2048 * DM / 4;
    for (size_t i0 = gt; i0 < m4; i0 += 4 * gs) {
      float4 v[4];
#pragma unroll
      for (int u = 0; u < 4; u++) {
        size_t i = i0 + u * gs;
        if (i >= m4) i = i0;
        v[u] = ((const float4*)P.in[I_MEM])[i];
      }
#pragma unroll
      for (int u = 0; u < 4; u++) {
        size_t i = i0 + u * gs;
        if (i < m4) ((uint2*)P.memb)[i] = make_uint2(pack2(v[u].x, v[u].y), pack2(v[u].z, v[u].w));
      }
    }
  }
}

DEV float4 ln_v_row(const Params& P, int l, int R, int lane) {
  float4 x = *(const float4*)(P.proj + (size_t)R * PRJ + 256 + lane * 4);
  float mu = wave_sum(x.x + x.y + x.z + x.w) * (1.f / 256.f);
  float4 d = make_float4(x.x - mu, x.y - mu, x.z - mu, x.w - mu);
  float var = wave_sum(d.x * d.x + d.y * d.y + d.z * d.z + d.w * d.w) * (1.f / 256.f);
  float rs = rsqrtf(var + 1e-5f);
  float4 g = *(const float4*)(P.in[I_LNVG] + l * 256 + lane * 4);
  float4 b = *(const float4*)(P.in[I_LNVB] + l * 256 + lane * 4);
  return make_float4(d.x * rs * g.x + b.x, d.y * rs * g.y + b.y, d.z * rs * g.z + b.z, d.w * rs * g.w + b.w);
}

DEV void mixer_A_item(const Params& P, int l, int c, int h, char* smem) {
  float* sv = (float*)smem;
  const int tid = tidx(), lane = tid & 63;
  const int w = __builtin_amdgcn_readfirstlane(tid >> 6);
  const int R0 = c * 128, b = c >> 4, t0 = (c & 15) * 128;
#pragma unroll 4
  for (int rr = 0; rr < 32; rr++) {
    int row = w * 32 + rr;
    float4 vn = ln_v_row(P, l, R0 + row, lane);
    if ((lane >> 4) == h) *(float4*)(sv + row * 64 + (lane & 15) * 4) = vn;
  }
  __syncthreads();
  if (t0 == 1920) {
#pragma unroll
    for (int i = 0; i < 8; i++) {
      int idx = tid + i * 256;
      int row = idx >> 4, c4 = (idx & 15) * 4;
      *(float4*)(P.out + O_CVP + ((size_t)(l * 8 + b) * 128 + row) * 256 + h * 64 + c4) = *(const float4*)(sv + row * 64 + c4);
    }
  }
  float acc[32];
#pragma unroll
  for (int i = 0; i < 32; i++) acc[i] = 0.f;
  float* sw = (float*)(smem + 32768);
  const float* wsrc = P.in[I_WSC] + (size_t)(l * 4 + h) * 16384 + (tid >> 1) * 128 + (tid & 1) * 8;
  float* wdst = sw + (tid >> 1) * 16 + (tid & 1) * 8;
  float4 wa = *(const float4*)(wsrc), wb = *(const float4*)(wsrc + 4);
  *(float4*)(wdst) = wa;
  *(float4*)(wdst + 4) = wb;
  wa = *(const float4*)(wsrc + 16);
  wb = *(const float4*)(wsrc + 20);
  __syncthreads();
  for (int c8 = 0; c8 < 8; c8++) {
    const int s0 = c8 * 16;
    const float* cw = sw + (c8 & 1) * 2048;
    float vv[16];
#pragma unroll
    for (int j = 0; j < 16; j++) vv[j] = sv[(s0 + j) * 64 + lane];
#pragma unroll
    for (int i = 0; i < 32; i++) {
      const int t = 4 * i + w;
      if (t >= s0) {
        const float4 q0 = *(const float4*)(cw + t * 16), q1 = *(const float4*)(cw + t * 16 + 4);
        const float4 q2 = *(const float4*)(cw + t * 16 + 8), q3 = *(const float4*)(cw + t * 16 + 12);
        const float wr[16] = {q0.x, q0.y, q0.z, q0.w, q1.x, q1.y, q1.z, q1.w, q2.x, q2.y, q2.z, q2.w, q3.x, q3.y, q3.z, q3.w};
        if (t >= s0 + 15) {
#pragma unroll
          for (int j = 0; j < 16; j++) acc[i] = fmaf(wr[j], vv[j], acc[i]);
        } else {
#pragma unroll
          for (int j = 0; j < 16; j++) acc[i] = fmaf((s0 + j <= t) ? wr[j] : 0.f, vv[j], acc[i]);
        }
      }
    }
    {
      float* d2 = wdst + ((c8 + 1) & 1) * 2048;
      *(float4*)(d2) = wa;
      *(float4*)(d2 + 4) = wb;
      const int cn = min(c8 + 2, 7) * 16;
      wa = *(const float4*)(wsrc + cn);
      wb = *(const float4*)(wsrc + cn + 4);
    }
    __syncthreads();
  }
#pragma unroll
  for (int i0 = 0; i0 < 32; i0 += 16) {
    float uu[16];
#pragma unroll
    for (int i = 0; i < 16; i++) uu[i] = P.proj[(size_t)(R0 + 4 * (i0 + i) + w) * PRJ + h * 64 + lane];
#pragma unroll
    for (int i = 0; i < 16; i++) {
      const int t = 4 * (i0 + i) + w;
      float z = acc[i0 + i] + P.in[I_BCH][(l * 4 + h) * 128 + t];
      P.mix[(size_t)(R0 + t) * DM + h * 64 + lane] = f2bf(uu[i] * z);
    }
  }
  __syncthreads();
}

DEV void mixer_pool_item(const Params& P, int l, int sub, int gi, char* smem) {
  float* xs = (float*)smem;
  float* sd = (float*)(smem + 20480);
  const int tid = tidx(), lane = tid & 63, w = tid >> 6;
  const int R0 = sub * 64;
  const bool samp = (R0 >= TP);
  const int win = 2 << gi;
  if (!samp) {
    const int b = R0 >> 11, t0 = R0 & 2047;
    for (int idx = tid; idx < 79 * 16; idx += 256) {
      int rr = idx >> 4, c4 = (idx & 15) * 4;
      int t = t0 - 15 + rr;
      float4 v = make_float4(0.f, 0.f, 0.f, 0.f);
      if (t >= 0) v = *(const float4*)(P.proj + (size_t)(b * 2048 + t) * PRJ + 512 + gi * 64 + c4);
      *(float4*)(xs + rr * 64 + c4) = v;
    }
    __syncthreads();
    for (int idx = tid; idx < 4096; idx += 256) {
      int tt = idx >> 6, cc = idx & 63;
      float s = 0.f;
      for (int j = 0; j < win; j++) s += xs[(tt + 15 - j) * 64 + cc];
      int pos = t0 + tt;
      float cnt = (float)min(win, pos + 1);
      sd[tt * 64 + cc] = s / cnt - xs[(tt + 15) * 64 + cc];
    }
  } else {
    const int sb0 = R0 - TP;
    for (int idx = tid; idx < 4096; idx += 256) {
      int tt = idx >> 6, cc = idx & 63;
      int sb = sb0 + tt;
      float x = P.proj[(size_t)(TP + sb) * PRJ + 512 + gi * 64 + cc];
      float s = x;
      const float* st = P.in[I_SPOOL] + (size_t)(l * 128 + sb) * 15 * 256 + gi * 64 + cc;
      for (int q = 16 - win; q < 15; q++) s += st[q * 256];
      sd[tt * 64 + cc] = s / (float)win - x;
    }
  }
  __syncthreads();
  float acc[16];
#pragma unroll
  for (int i = 0; i < 16; i++) acc[i] = 0.f;
  const float* wp = P.in[I_WPOOL] + (size_t)(l * 4 + gi) * 4096 + lane;
#pragma unroll 4
  for (int c0 = 0; c0 < 64; c0 += 4) {
    float w0 = wp[(c0 + 0) * 64], w1 = wp[(c0 + 1) * 64], w2 = wp[(c0 + 2) * 64], w3 = wp[(c0 + 3) * 64];
#pragma unroll
    for (int i = 0; i < 16; i++) {
      float4 dd = *(const float4*)(sd + (w * 16 + i) * 64 + c0);
      acc[i] = fmaf(dd.x, w0, fmaf(dd.y, w1, fmaf(dd.z, w2, fmaf(dd.w, w3, acc[i]))));
    }
  }
  const float sc = P.in[I_PSCALE][l * 256 + gi * 64 + lane];
#pragma unroll
  for (int i = 0; i < 16; i++) P.mix[(size_t)(R0 + w * 16 + i) * DM + 256 + gi * 64 + lane] = f2bf(acc[i] * sc);
  __syncthreads();
}

DEV float xs_val(const Params& P, int l, int R, int col) {
  float pd = P.proj[(size_t)R * PRJ + 1536 + col];
  float prev;
  if (R >= TP) prev = P.in[I_SSHIFT][(size_t)(l * 128 + (R - TP)) * 896 + col];
  else prev = ((R & 2047) > 0) ? P.proj[(size_t)(R - 1) * PRJ + 1536 + col] : 0.f;
  return pd + (prev - pd) * P.in[I_MUD][l * 896 + col];
}

DEV void mixer_Dprep_item(const Params& P, int l, int st, char* smem) {
  float* sl = (float*)smem;
  const int tid = tidx(), lane = tid & 63, h = tid >> 6;
  const int R0 = st * 16;
#pragma unroll
  for (int idx = tid; idx < 2048; idx += 256) {
    int tt = idx >> 7, j = idx & 127;
    float x = xs_val(P, l, R0 + tt, 768 + j);
    float a = (j < 32) ? ftanh(x) : ((j < 64) ? x : sigm(x));
    sl[idx] = a;
  }
  __syncthreads();
  const int cn = h * 64 + lane;
  float accw[16], acca[16], accg[16];
#pragma unroll
  for (int i = 0; i < 16; i++) { accw[i] = 0.f; acca[i] = 0.f; accg[i] = 0.f; }
  const float* w2p = P.in[I_W2] + (size_t)l * 32 * 256 + cn;
  const float* a2p = P.in[I_A2] + (size_t)l * 32 * 256 + cn;
  const float* g2p = P.in[I_G2] + (size_t)l * 64 * 256 + cn;
#pragma unroll 2
  for (int j0 = 0; j0 < 32; j0 += 4) {
    float wv0 = w2p[(j0 + 0) * 256], wv1 = w2p[(j0 + 1) * 256], wv2 = w2p[(j0 + 2) * 256], wv3 = w2p[(j0 + 3) * 256];
    float av0 = a2p[(j0 + 0) * 256], av1 = a2p[(j0 + 1) * 256], av2 = a2p[(j0 + 2) * 256], av3 = a2p[(j0 + 3) * 256];
#pragma unroll
    for (int tt = 0; tt < 16; tt++) {
      float4 tw = *(const float4*)(sl + tt * 128 + j0);
      float4 ta = *(const float4*)(sl + tt * 128 + 32 + j0);
      accw[tt] = fmaf(tw.x, wv0, fmaf(tw.y, wv1, fmaf(tw.z, wv2, fmaf(tw.w, wv3, accw[tt]))));
      acca[tt] = fmaf(ta.x, av0, fmaf(ta.y, av1, fmaf(ta.z, av2, fmaf(ta.w, av3, acca[tt]))));
    }
  }
#pragma unroll 4
  for (int j0 = 0; j0 < 64; j0 += 4) {
    float gv0 = g2p[(j0 + 0) * 256], gv1 = g2p[(j0 + 1) * 256], gv2 = g2p[(j0 + 2) * 256], gv3 = g2p[(j0 + 3) * 256];
#pragma unroll
    for (int tt = 0; tt < 16; tt++) {
      float4 tg = *(const float4*)(sl + tt * 128 + 64 + j0);
      accg[tt] = fmaf(tg.x, gv0, fmaf(tg.y, gv1, fmaf(tg.z, gv2, fmaf(tg.w, gv3, accg[tt]))));
    }
  }
  const float w0 = P.in[I_W0][l * 256 + cn], a0 = P.in[I_A0][l * 256 + cn];
  const float kkw = P.in[I_KK][l * 256 + cn], kaw = P.in[I_KA][l * 256 + cn];
  float rr_[16], kk_[16], vv_[16];
#pragma unroll
  for (int tt = 0; tt < 16; tt++) {
    rr_[tt] = xs_val(P, l, R0 + tt, cn);
    kk_[tt] = xs_val(P, l, R0 + tt, 256 + cn);
    vv_[tt] = xs_val(P, l, R0 + tt, 512 + cn);
  }
#pragma unroll
  for (int tt = 0; tt < 16; tt++) {
    const int R = R0 + tt;
    float r = rr_[tt], k = kk_[tt], v = vv_[tt];
    float lw = w0 + accw[tt];
    float wlog = -softplus(-lw) - 0.5f;
    float decay = __expf(-__expf(wlog));
    float a = sigm(a0 + acca[tt]);
    float kk = k * kkw;
    float nrm = wave_sum(kk * kk);
    kk *= rsqrtf(fmaxf(nrm, 1e-12f));
    float k2 = k * (1.f + (a - 1.f) * kaw);
    float* o = P.scanin + ((size_t)R * 4 + h) * 384 + lane;
    o[0] = decay; o[64] = k2; o[128] = kk * a; o[192] = -kk; o[256] = r; o[320] = v;
    P.gbuf[(size_t)R * 256 + cn] = accg[tt];
  }
  __syncthreads();
}


DEV void phase_dprep(const Params& P, int l, char* smem) {
  float* sl = (float*)smem;
  constexpr int TK = 17;
  const int tid = tidx(), lane = tid & 63, h = tid >> 6;
  const int cn = h * 64 + lane;
  float w2v[32], a2v[32], g2v[64];
  {
    const float* w2p = P.in[I_W2] + (size_t)l * 32 * 256 + cn;
    const float* a2p = P.in[I_A2] + (size_t)l * 32 * 256 + cn;
    const float* g2p = P.in[I_G2] + (size_t)l * 64 * 256 + cn;
#pragma unroll
    for (int j = 0; j < 32; j++) { w2v[j] = w2p[j * 256]; a2v[j] = a2p[j * 256]; }
#pragma unroll
    for (int j = 0; j < 64; j++) g2v[j] = g2p[j * 256];
  }
  const float w0 = P.in[I_W0][l * 256 + cn], a0 = P.in[I_A0][l * 256 + cn];
  const float kkw = P.in[I_KK][l * 256 + cn], kaw = P.in[I_KA][l * 256 + cn];
  for (int item = blockIdx.x; item < (TT + TK - 1) / TK; item += gridDim.x) {
    const int R0 = item * TK;
    const int ntok = min(TK, TT - R0);
    __syncthreads();
#pragma unroll 2
    for (int idx = tid; idx < ntok * 128; idx += 256) {
      int tt = idx >> 7, j = idx & 127;
      float x = xs_val(P, l, R0 + tt, 768 + j);
      float a = (j < 32) ? ftanh(x) : ((j < 64) ? x : sigm(x));
      sl[idx] = a;
    }
    __syncthreads();
    float rN = xs_val(P, l, R0, cn), kN = xs_val(P, l, R0, 256 + cn), vN = xs_val(P, l, R0, 512 + cn);
#pragma unroll 1
    for (int tt = 0; tt < ntok; tt++) {
      const int R = R0 + tt;
      const float r = rN, k = kN, v = vN;
      {
        const int Rn = R0 + ((tt + 1 < ntok) ? tt + 1 : 0);
        rN = xs_val(P, l, Rn, cn); kN = xs_val(P, l, Rn, 256 + cn); vN = xs_val(P, l, Rn, 512 + cn);
      }
      float accw = 0.f, acca = 0.f, accg = 0.f;
      const float* sr = sl + tt * 128;
#pragma unroll
      for (int j0 = 0; j0 < 32; j0 += 4) {
        float4 tw = *(const float4*)(sr + j0);
        float4 ta = *(const float4*)(sr + 32 + j0);
        accw = fmaf(tw.x, w2v[j0], fmaf(tw.y, w2v[j0 + 1], fmaf(tw.z, w2v[j0 + 2], fmaf(tw.w, w2v[j0 + 3], accw))));
        acca = fmaf(ta.x, a2v[j0], fmaf(ta.y, a2v[j0 + 1], fmaf(ta.z, a2v[j0 + 2], fmaf(ta.w, a2v[j0 + 3], acca))));
      }
#pragma unroll
      for (int j0 = 0; j0 < 64; j0 += 4) {
        float4 tg = *(const float4*)(sr + 64 + j0);
        accg = fmaf(tg.x, g2v[j0], fmaf(tg.y, g2v[j0 + 1], fmaf(tg.z, g2v[j0 + 2], fmaf(tg.w, g2v[j0 + 3], accg))));
      }
      float lw = w0 + accw;
      float wlog = -softplus(-lw) - 0.5f;
      float decay = __expf(-__expf(wlog));
      float a = sigm(a0 + acca);
      float kk = k * kkw;
      float nrm = wave_sum(kk * kk);
      kk *= rsqrtf(fmaxf(nrm, 1e-12f));
      float k2 = k * (1.f + (a - 1.f) * kaw);
      float* o = P.scanin + ((size_t)R * 4 + h) * 384 + lane;
      o[0] = decay; o[64] = k2; o[128] = kk * a; o[192] = -kk; o[256] = r; o[320] = v;
      P.gbuf[(size_t)R * 256 + cn] = accg;
    }
  }
  __syncthreads();
}

DEV void phase_pool(const Params& P, int l, char* smem, int bid, int nb) {
  float* xs = (float*)smem;
  float* sd = (float*)(smem + 20480);
  const int tid = tidx(), lane = tid & 63, w = tid >> 6;
  const int gi = bid & 3;
  const int win = 2 << gi;
  const float rwin = 1.f / (float)win;
  float wv[64];
  {
    const float* wp = P.in[I_WPOOL] + (size_t)(l * 4 + gi) * 4096 + lane;
#pragma unroll
    for (int c = 0; c < 64; c++) wv[c] = wp[c * 64];
  }
  const float sc = P.in[I_PSCALE][l * 256 + gi * 64 + lane];
  const int nsub = TT / 64;
  for (int sub = (bid >> 2); sub < nsub; sub += (nb >> 2)) {
    const int R0 = sub * 64;
    __syncthreads();
    if (R0 < TP) {
      const int b = R0 >> 11, t0 = R0 & 2047;
#pragma unroll
      for (int i = 0; i < 5; i++) {
        int idx = tid + i * 256;
        if (idx < 79 * 16) {
          int rr = idx >> 4, c4 = (idx & 15) * 4;
          int t = t0 - 15 + rr;
          float4 v = make_float4(0.f, 0.f, 0.f, 0.f);
          if (t >= 0) v = *(const float4*)(P.proj + (size_t)(b * 2048 + t) * PRJ + 512 + gi * 64 + c4);
          *(float4*)(xs + rr * 64 + c4) = v;
        }
      }
      __syncthreads();
      {
        const int cc = lane, tb = w * 16;
        float s = 0.f;
#pragma unroll 1
        for (int j = 1; j < win; j++) s += xs[(tb + 15 - j) * 64 + cc];
#pragma unroll 2
        for (int i = 0; i < 16; i++) {
          const int tt = tb + i;
          const float xn = xs[(tt + 15) * 64 + cc];
          s += xn;
          const int pos = t0 + tt;
          const float rc = (pos + 1 >= win) ? rwin : frcp((float)(pos + 1));
          sd[tt * 64 + cc] = s * rc - xn;
          s -= xs[(tt + 16 - win) * 64 + cc];
        }
      }
    } else {
      const int sb0 = R0 - TP;
#pragma unroll 1
      for (int idx = tid; idx < 4096; idx += 256) {
        int tt = idx >> 6, cc = idx & 63;
        int sb = sb0 + tt;
        float x = P.proj[(size_t)(TP + sb) * PRJ + 512 + gi * 64 + cc];
        float s = x;
        const float* st = P.in[I_SPOOL] + (size_t)(l * 128 + sb) * 15 * 256 + gi * 64 + cc;
#pragma unroll 1
        for (int q = 16 - win; q < 15; q++) s += st[q * 256];
        sd[tt * 64 + cc] = s * rwin - x;
      }
    }
    __syncthreads();
#pragma unroll 1
    for (int i = 0; i < 16; i++) {
      const float* dr = sd + (w * 16 + i) * 64;
      float acc = 0.f;
#pragma unroll
      for (int c0 = 0; c0 < 64; c0 += 4) {
        float4 dd = *(const float4*)(dr + c0);
        acc = fmaf(dd.x, wv[c0], fmaf(dd.y, wv[c0 + 1], fmaf(dd.z, wv[c0 + 2], fmaf(dd.w, wv[c0 + 3], acc))));
      }
      P.mix[(size_t)(R0 + w * 16 + i) * DM + 256 + gi * 64 + lane] = f2bf(acc * sc);
    }
  }
  __syncthreads();
}

DEV float conv_z(const Params& P, int R, int c) {
  return P.proj[(size_t)R * PRJ + 1024 + c] * P.proj[(size_t)R * PRJ + 1280 + c];
}

DEV void phase_mixer_rest(const Params& P, int l, char* smem, int bid, int nb) {
  const int tid = tidx(), lane = tid & 63, w = tid >> 6;
#ifndef MIXREP
#define MIXREP 0
#endif
  for (int rep = 0; rep < 1 + (MIXREP & 1); rep++)
  for (int it = bid; it < 512; it += nb) mixer_A_item(P, l, it >> 2, it & 3, smem);
  for (int rep = 0; rep < 1 + ((MIXREP >> 2) & 1); rep++) phase_pool(P, l, smem, bid, nb);
  for (int sb = bid * 4 + w; sb < TS; sb += nb * 4) {
    const int R = TP + sb;
    float4 vn = ln_v_row(P, l, R, lane);
    *(float4*)(P.out + O_CVS + (size_t)(l * 128 + sb) * 256 + lane * 4) = vn;
    const int h = lane >> 4;
    float ws00 = P.in[I_WSC][(size_t)(l * 4 + h) * 16384];
    float bs0 = P.in[I_BCH][(l * 4 + h) * 128];
    float4 u = *(const float4*)(P.proj + (size_t)R * PRJ + lane * 4);
    uint2 pk;
    pk.x = pack2(u.x * (ws00 * vn.x + bs0), u.y * (ws00 * vn.y + bs0));
    pk.y = pack2(u.z * (ws00 * vn.z + bs0), u.w * (ws00 * vn.w + bs0));
    *(uint2*)(P.mix + (size_t)R * DM + lane * 4) = pk;
  }
  const int gt = bid * 256 + tid, gs = nb * 256;
  {
    const int ng = TT * 64;
    for (int g0 = gt; g0 < ng; g0 += 2 * gs) {
      float4 z0[2], z1[2], z2[2], bg[2];
      int Rr[2], cc[2];
      bool ok[2];
#pragma unroll
      for (int u = 0; u < 2; u++) {
        int g = g0 + u * gs;
        ok[u] = g < ng;
        if (!ok[u]) g = g0;
        int R = g >> 6, c = (g & 63) * 4;
        Rr[u] = R; cc[u] = c;
        const float* pr = P.proj + (size_t)R * PRJ;
        float4 a = *(const float4*)(pr + 1024 + c), b = *(const float4*)(pr + 1280 + c);
        z0[u] = make_float4(a.x * b.x, a.y * b.y, a.z * b.z, a.w * b.w);
        bg[u] = *(const float4*)(pr + 768 + c);
        if (R >= TP) {
          const float* sc = P.in[I_SCONV] + (size_t)(l * 128 + (R - TP)) * 512 + c;
          z2[u] = *(const float4*)(sc);
          z1[u] = *(const float4*)(sc + 256);
        } else {
          int t = R & 2047;
          z1[u] = make_float4(0.f, 0.f, 0.f, 0.f);
          z2[u] = make_float4(0.f, 0.f, 0.f, 0.f);
          if (t >= 1) {
            float4 a1 = *(const float4*)(pr - PRJ + 1024 + c), b1 = *(const float4*)(pr - PRJ + 1280 + c);
            z1[u] = make_float4(a1.x * b1.x, a1.y * b1.y, a1.z * b1.z, a1.w * b1.w);
          }
          if (t >= 2) {
            float4 a2 = *(const float4*)(pr - 2 * PRJ + 1024 + c), b2 = *(const float4*)(pr - 2 * PRJ + 1280 + c);
            z2[u] = make_float4(a2.x * b2.x, a2.y * b2.y, a2.z * b2.z, a2.w * b2.w);
          }
        }
      }
#pragma unroll
      for (int u = 0; u < 2; u++) {
        if (!ok[u]) continue;
        const float* cw = P.in[I_CONVW] + l * 768 + cc[u];
        float4 w0 = *(const float4*)(cw), w1 = *(const float4*)(cw + 256), w2 = *(const float4*)(cw + 512);
        float y0 = bg[u].x * (w0.x * z2[u].x + w1.x * z1[u].x + w2.x * z0[u].x);
        float y1 = bg[u].y * (w0.y * z2[u].y + w1.y * z1[u].y + w2.y * z0[u].y);
        float y2 = bg[u].z * (w0.z * z2[u].z + w1.z * z1[u].z + w2.z * z0[u].z);
        float y3 = bg[u].w * (w0.w * z2[u].w + w1.w * z1[u].w + w2.w * z0[u].w);
        *(uint2*)(P.mix + (size_t)Rr[u] * DM + 512 + cc[u]) = make_uint2(pack2(y0, y1), pack2(y2, y3));
      }
    }
  }
  for (int idx = gt; idx < 8 * 15 * 256; idx += gs) {
    int c = idx & 255, j = (idx >> 8) % 15, b = idx / (15 * 256);
    P.out[O_PLP + (size_t)l * 8 * 15 * 256 + idx] = P.proj[(size_t)(b * 2048 + 2033 + j) * PRJ + 512 + c];
  }
  for (int idx = gt; idx < 128 * 15 * 256; idx += gs) {
    int c = idx & 255, j = (idx >> 8) % 15, sb = idx / (15 * 256);
    float v = (j < 14) ? P.in[I_SPOOL][(size_t)(l * 128 + sb) * 15 * 256 + (j + 1) * 256 + c] : P.proj[(size_t)(TP + sb) * PRJ + 512 + c];
    P.out[O_PLS + (size_t)l * 128 * 15 * 256 + idx] = v;
  }
  for (int idx = gt; idx < 8 * 2 * 256; idx += gs) {
    int c = idx & 255, j = (idx >> 8) & 1, b = idx >> 9;
    P.out[O_CNP + (size_t)l * 8 * 512 + idx] = conv_z(P, b * 2048 + 2046 + j, c);
  }
  for (int idx = gt; idx < 128 * 2 * 256; idx += gs) {
    int c = idx & 255, j = (idx >> 8) & 1, sb = idx >> 9;
    float v = (j == 0) ? P.in[I_SCONV][(size_t)(l * 128 + sb) * 512 + 256 + c] : conv_z(P, TP + sb, c);
    P.out[O_CNS + (size_t)l * 128 * 512 + idx] = v;
  }
  for (int idx = gt; idx < 8 * 896; idx += gs) {
    int c = idx % 896, b = idx / 896;
    P.out[O_SHP + (size_t)l * 8 * 896 + idx] = P.proj[(size_t)(b * 2048 + 2047) * PRJ + 1536 + c];
  }
  for (int idx = gt; idx < 128 * 896; idx += gs) {
    int c = idx % 896, sb = idx / 896;
    P.out[O_SHS + (size_t)l * 128 * 896 + idx] = P.proj[(size_t)(TP + sb) * PRJ + 1536 + c];
  }
}

typedef __attribute__((ext_vector_type(2))) float f32x2;
struct WkvState { f32x2 a, b; };
DEV float wkv_step(WkvState& s, f32x4 w, f32x4 k, f32x4 ka, f32x4 nk, f32x4 r, float v) {
  f32x2 t = s.a * nk.xy;
  t = __builtin_elementwise_fma(s.b, nk.zw, t);
  float p = row16_sum(t.x + t.y);
  f32x2 p2 = (f32x2){p, p}, v2 = (f32x2){v, v};
  s.a = __builtin_elementwise_fma(s.a, w.xy, __builtin_elementwise_fma(p2, ka.xy, v2 * k.xy));
  s.b = __builtin_elementwise_fma(s.b, w.zw, __builtin_elementwise_fma(p2, ka.zw, v2 * k.zw));
  f32x2 q = s.a * r.xy;
  q = __builtin_elementwise_fma(s.b, r.zw, q);
  return row16_sum(q.x + q.y);
}

DEV void phase_scan(const Params& P, int l, char* smem, int cu_slot, int p_first, int p_stride, int s_first, int s_stride) {
  const int tid = tidx(), lane = tid & 63, w = tid >> 6;
  const int kq = lane & 15, rl = lane >> 4;
  unsigned* jc = P.bar + XB_JOBCTR(l);
  volatile unsigned* jobw = (volatile unsigned*)(smem + 49152 + 2048);
  (void)jc; (void)jobw; (void)cu_slot;
  {
  const bool do_sample = true;
  if (p_stride > 0)
  for (int job = p_first; job < 128; job += p_stride) {
    const int b = job >> 4, h = (job >> 2) & 3, rg = job & 3;
    const int row = rg * 16 + w * 4 + rl;
    f32x4* buf0 = (f32x4*)smem;
    f32x4* buf1 = (f32x4*)(smem + 24576);
    const float* src = P.scanin + ((size_t)(b * 2048) * 4 + h) * 384;
    f32x4 rgA[6], rgB[6];
#define SCAN_ISSUE(RG, c)                                                                  \
  {                                                                                        \
    const int cc_ = min((c), 127);                                                         \
    _Pragma("unroll") for (int i = 0; i < 6; i++) {                                        \
      int idx = tid + i * 256;                                                             \
      int stp = idx / 96, off = idx - stp * 96;                                            \
      RG[i] = *(const f32x4*)(src + (size_t)(cc_ * 16 + stp) * 1536 + off * 4);            \
    }                                                                                      \
  }
#define SCAN_CHUNK(c, CUR, NXT, RG)                                                        \
  {                                                                                        \
    __syncthreads();                                                                       \
    _Pragma("unroll") for (int i = 0; i < 6; i++) NXT[tid + i * 256] = RG[i];              \
    SCAN_ISSUE(RG, (c) + 3)                                                                \
    const float* cb = (const float*)CUR + kq * 4;                                          \
    const float* vb = (const float*)CUR + 320 + row;                                       \
    float* so = (float*)(smem + 49152) + ((c) & 1) * 256;                                  \
    {                                                                                      \
      const float* sp_ = (const float*)(smem + 49152) + (((c) + 1) & 1) * 256;             \
      const int cm_ = max((c) - 1, 0);                                                     \
      P.obuf[(size_t)(b * 2048 + cm_ * 16 + (tid >> 4)) * 256 + h * 64 + rg * 16 + (tid & 15)] = sp_[tid]; \
    }                                                                                      \
    f32x4 w4 = *(const f32x4*)(cb), k4 = *(const f32x4*)(cb + 64), a4 = *(const f32x4*)(cb + 128); \
    f32x4 n4 = *(const f32x4*)(cb + 192), r4 = *(const f32x4*)(cb + 256);                  \
    float v = vb[0];                                                                       \
    _Pragma("unroll 4") for (int st = 0; st < 16; st++) {                                  \
      const int sn = ((st + 1) & 15) * 384;                                                \
      f32x4 w4n = *(const f32x4*)(cb + sn), k4n = *(const f32x4*)(cb + sn + 64), a4n = *(const f32x4*)(cb + sn + 128); \
      f32x4 n4n = *(const f32x4*)(cb + sn + 192), r4n = *(const f32x4*)(cb + sn + 256);    \
      float vn = vb[sn];                                                                   \
      float o = wkv_step(s, w4, k4, a4, n4, r4, v);                                        \
      so[st * 16 + w * 4 + rl] = o;                                                        \
      asm volatile("" : "+v"(w4n), "+v"(k4n), "+v"(a4n), "+v"(n4n), "+v"(r4n), "+v"(vn));  \
      w4 = w4n; k4 = k4n; a4 = a4n; n4 = n4n; r4 = r4n; v = vn;                            \
    }                                                                                      \
  }
    __syncthreads();
    SCAN_ISSUE(rgA, 0)
#pragma unroll
    for (int i = 0; i < 6; i++) buf0[tid + i * 256] = rgA[i];
    SCAN_ISSUE(rgA, 1)
    SCAN_ISSUE(rgB, 2)
    WkvState s; s.a = (f32x2){0.f, 0.f}; s.b = (f32x2){0.f, 0.f};
    for (int c = 0; c < 128; c += 2) {
      SCAN_CHUNK(c, buf0, buf1, rgA)
      SCAN_CHUNK(c + 1, buf1, buf0, rgB)
    }
    __syncthreads();
    P.obuf[(size_t)(b * 2048 + 127 * 16 + (tid >> 4)) * 256 + h * 64 + rg * 16 + (tid & 15)] = ((const float*)(smem + 49152))[256 + tid];
    *(float4*)(P.out + O_WKP + ((size_t)((l * 8 + b) * 4 + h) * 64 + row) * 64 + kq * 4) = make_float4(s.a.x, s.a.y, s.b.x, s.b.y);
    __syncthreads();
  }
  if (do_sample)
  if (s_stride > 0)
  for (int sj = s_first; sj < 2048; sj += s_stride) {
    const int wj = sj * 4 + w;
    const int sb = wj >> 6, h = (wj >> 4) & 3, rg = wj & 15;
    const int row = rg * 4 + rl;
    const int R = TP + sb;
    const float* sp = P.scanin + ((size_t)R * 4 + h) * 384;
    f32x4 w4 = *(const f32x4*)(sp + kq * 4);
    f32x4 k4 = *(const f32x4*)(sp + 64 + kq * 4);
    f32x4 a4 = *(const f32x4*)(sp + 128 + kq * 4);
    f32x4 n4 = *(const f32x4*)(sp + 192 + kq * 4);
    f32x4 r4 = *(const f32x4*)(sp + 256 + kq * 4);
    float v = sp[320 + row];
    const size_t so = ((size_t)((l * 128 + sb) * 4 + h) * 64 + row) * 64 + kq * 4;
    float4 s0 = *(const float4*)(P.in[I_SWKV] + so);
    WkvState s; s.a = (f32x2){s0.x, s0.y}; s.b = (f32x2){s0.z, s0.w};
    float o = wkv_step(s, w4, k4, a4, n4, r4, v);
    if (kq == 0) P.obuf[(size_t)R * 256 + h * 64 + row] = o;
    *(float4*)(P.out + O_WKS + so) = make_float4(s.a.x, s.a.y, s.b.x, s.b.y);
  }
  }
}

DEV void phase_dpost(const Params& P, int l) {
  const int lane = tidx() & 63;
  const int gw = blockIdx.x * 4 + (tidx() >> 6), nw = gridDim.x * 4;
  for (int it0 = gw; it0 < TT * 4; it0 += 4 * nw) {
    float o[4], k2[4], r[4], v[4], g[4];
    int Rr[4], cnn[4];
    bool ok[4];
#pragma unroll
    for (int u = 0; u < 4; u++) {
      int it = it0 + u * nw;
      ok[u] = it < TT * 4;
      if (!ok[u]) it = it0;
      const int R = it >> 2, h = it & 3;
      const int cn = h * 64 + lane;
      Rr[u] = R; cnn[u] = cn;
      o[u] = P.obuf[(size_t)R * 256 + cn];
      const float* sp = P.scanin + ((size_t)R * 4 + h) * 384 + lane;
      k2[u] = sp[64]; r[u] = sp[256]; v[u] = sp[320];
      g[u] = P.gbuf[(size_t)R * 256 + cn];
    }
#pragma unroll
    for (int u = 0; u < 4; u++) {
      const int cn = cnn[u];
      float mu = wave_sum(o[u]) * (1.f / 64.f);
      float d = o[u] - mu;
      float var = wave_sum(d * d) * (1.f / 64.f);
      float on = d * rsqrtf(var + 64e-5f) * P.in[I_LNXG][l * 256 + cn] + P.in[I_LNXB][l * 256 + cn];
      float bon = wave_sum(r[u] * k2[u] * P.in[I_RK][l * 256 + cn]) * v[u];
      float y = (on + bon) * g[u];
      if (ok[u]) P.mix[(size_t)Rr[u] * DM + 768 + cn] = f2bf(y);
    }
  }
}

DEV void phase_ln(const Params& P, const float* g, const float* bta, float* dstf) {
  const int lane = tidx() & 63;
  const int gw = blockIdx.x * 4 + (tidx() >> 6), nw = gridDim.x * 4;
  for (int R0 = gw; R0 < TT; R0 += 2 * nw) {
    float4 x[2][4];
    int Rr[2];
    bool ok[2];
#pragma unroll
    for (int u = 0; u < 2; u++) {
      int R = R0 + u * nw;
      ok[u] = R < TT;
      if (!ok[u]) R = R0;
      Rr[u] = R;
      const float* src = P.pre + (size_t)R * DM;
#pragma unroll
      for (int i = 0; i < 4; i++) x[u][i] = *(const float4*)(src + i * 256 + lane * 4);
    }
#pragma unroll
    for (int u = 0; u < 2; u++) {
      float s = 0.f;
#pragma unroll
      for (int i = 0; i < 4; i++) s += x[u][i].x + x[u][i].y + x[u][i].z + x[u][i].w;
      float mu = wave_sum(s) * (1.f / 1024.f);
      float vs = 0.f;
#pragma unroll
      for (int i = 0; i < 4; i++) {
        x[u][i].x -= mu; x[u][i].y -= mu; x[u][i].z -= mu; x[u][i].w -= mu;
        vs += x[u][i].x * x[u][i].x + x[u][i].y * x[u][i].y + x[u][i].z * x[u][i].z + x[u][i].w * x[u][i].w;
      }
      float rs = rsqrtf(wave_sum(vs) * (1.f / 1024.f) + 1e-5f);
      if (ok[u]) {
#pragma unroll
        for (int i = 0; i < 4; i++) {
          int c = i * 256 + lane * 4;
          float4 gg = *(const float4*)(g + c), bb = *(const float4*)(bta + c);
          float4 y = make_float4(x[u][i].x * rs * gg.x + bb.x, x[u][i].y * rs * gg.y + bb.y, x[u][i].z * rs * gg.z + bb.z, x[u][i].w * rs * gg.w + bb.w);
          *(float4*)(dstf + (size_t)Rr[u] * DM + c) = y;
          *(uint2*)(P.xb + (size_t)Rr[u] * DM + c) = make_uint2(pack2(y.x, y.y), pack2(y.z, y.w));
        }
      }
    }
  }
}

DEV void attn_prompt_item(const Params& P, int l, int b, int h, int qt, char* smem) {
  u16* sQ = (u16*)smem;
  u16* sK = (u16*)(smem + 8192);
  const int tid = tidx(), lane = tid & 63, wave = tid >> 6;
  const int fr = lane & 15, fq = lane >> 4;
  const int lr = tid >> 3, ls = tid & 7;
  const int R0 = b * 2048 + qt * 64;
  const u16* kbp = P.kb + ((size_t)l * 2048 + b * 256) * 1024 + h * 256;
  const u16* vtp = P.vtb + ((size_t)(l * 8 + b) * 1024 + h * 256) * 256;
  f32x4 st[16];
#pragma unroll
  for (int i = 0; i < 16; i++) st[i] = (f32x4){0.f, 0.f, 0.f, 0.f};
  u32x4 pf[10];
  const u16* qsrc = P.qb + (size_t)(R0 + lr) * DM + h * 256 + ls * 8;
  const u16* ksrc = kbp + (size_t)lr * 1024 + ls * 8;
  const u16* vsrc = vtp + (size_t)lr * 256 + ls * 8;
  const int loff = lr * 64 + ((ls ^ (lr & 7)) * 8);
#pragma unroll
  for (int i = 0; i < 8; i++) pf[i] = *(const u32x4*)(ksrc + (size_t)(i * 32) * 1024);
#pragma unroll
  for (int i = 0; i < 2; i++) pf[8 + i] = *(const u32x4*)(qsrc + (size_t)(i * 32) * DM);
  for (int kc = 0; kc < 4; kc++) {
    __syncthreads();
#pragma unroll
    for (int i = 0; i < 8; i++) *(u32x4*)(sK + loff + i * 2048) = pf[i];
#pragma unroll
    for (int i = 0; i < 2; i++) *(u32x4*)(sQ + loff + i * 2048) = pf[8 + i];
    __syncthreads();
    if (kc < 3) {
#pragma unroll
      for (int i = 0; i < 8; i++) pf[i] = *(const u32x4*)(ksrc + (size_t)(i * 32) * 1024 + (kc + 1) * 64);
#pragma unroll
      for (int i = 0; i < 2; i++) pf[8 + i] = *(const u32x4*)(qsrc + (size_t)(i * 32) * DM + (kc + 1) * 64);
    } else {
#pragma unroll
      for (int i = 0; i < 8; i++) pf[i] = *(const u32x4*)(vsrc + (size_t)(i * 32) * 256);
    }
#pragma unroll
    for (int ks = 0; ks < 2; ks++) {
      const int slot = ks * 4 + fq;
      const int qrow = wave * 16 + fr;
      bf16x8 bq = *(const bf16x8*)(sQ + qrow * 64 + ((slot ^ (qrow & 7)) * 8));
#pragma unroll
      for (int mi = 0; mi < 16; mi++) {
        int krow = mi * 16 + fr;
        bf16x8 ak = *(const bf16x8*)(sK + krow * 64 + ((slot ^ (krow & 7)) * 8));
        st[mi] = __builtin_amdgcn_mfma_f32_16x16x32_bf16(ak, bq, st[mi], 0, 0, 0);
      }
    }
  }
  float mx = -3.0e38f;
#pragma unroll
  for (int mi = 0; mi < 16; mi++)
#pragma unroll
    for (int e = 0; e < 4; e++) mx = fmaxf(mx, st[mi][e]);
  mx = fmaxf(mx, __shfl_xor(mx, 16));
  mx = fmaxf(mx, __shfl_xor(mx, 32));
  float sum = 0.f;
#pragma unroll
  for (int mi = 0; mi < 16; mi++)
#pragma unroll
    for (int e = 0; e < 4; e++) {
      float p = __expf(st[mi][e] - mx);
      st[mi][e] = p;
      sum += p;
    }
  sum += __shfl_xor(sum, 16);
  sum += __shfl_xor(sum, 32);
  const float inv = 1.f / sum;
  unsigned pb[16][2];
#pragma unroll
  for (int mi = 0; mi < 16; mi++) {
    pb[mi][0] = pack2(st[mi][0] * inv, st[mi][1] * inv);
    pb[mi][1] = pack2(st[mi][2] * inv, st[mi][3] * inv);
  }
  f32x4 ot[16];
#pragma unroll
  for (int i = 0; i < 16; i++) ot[i] = (f32x4){0.f, 0.f, 0.f, 0.f};
  for (int mc = 0; mc < 4; mc++) {
    __syncthreads();
#pragma unroll
    for (int i = 0; i < 8; i++) *(u32x4*)(sK + loff + i * 2048) = pf[i];
    __syncthreads();
    {
      const int mn = min(mc + 1, 3);
#pragma unroll
      for (int i = 0; i < 8; i++) pf[i] = *(const u32x4*)(vsrc + (size_t)(i * 32) * 256 + mn * 64);
    }
#pragma unroll
    for (int kkl = 0; kkl < 2; kkl++) {
      unsigned p0 = 0, p1 = 0, p2 = 0, p3 = 0;
#pragma unroll
      for (int m2 = 0; m2 < 4; m2++) {
        if (m2 == mc) {
          p0 = pb[(m2 * 2 + kkl) * 2][0]; p1 = pb[(m2 * 2 + kkl) * 2][1];
          p2 = pb[(m2 * 2 + kkl) * 2 + 1][0]; p3 = pb[(m2 * 2 + kkl) * 2 + 1][1];
        }
      }
      union { unsigned u[4]; bf16x8 v; } bp;
      bp.u[0] = p0; bp.u[1] = p1; bp.u[2] = p2; bp.u[3] = p3;
#pragma unroll
      for (int dt = 0; dt < 16; dt++) {
        int d = dt * 16 + fr;
        const u16* rowp = sK + d * 64 + (fq & 1) * 4;
        uint2 lo = *(const uint2*)(rowp + (((kkl * 4 + (fq >> 1)) ^ (d & 7)) * 8));
        uint2 hi = *(const uint2*)(rowp + (((kkl * 4 + 2 + (fq >> 1)) ^ (d & 7)) * 8));
        union { unsigned u[4]; bf16x8 v; } av;
        av.u[0] = lo.x; av.u[1] = lo.y; av.u[2] = hi.x; av.u[3] = hi.y;
        ot[dt] = __builtin_amdgcn_mfma_f32_16x16x32_bf16(av.v, bp.v, ot[dt], 0, 0, 0);
      }
    }
  }
  u16* op = P.ao + (size_t)(R0 + wave * 16 + fr) * DM + h * 256 + fq * 4;
#pragma unroll
  for (int dt = 0; dt < 16; dt++) *(uint2*)(op + dt * 16) = make_uint2(pack2(ot[dt][0], ot[dt][1]), pack2(ot[dt][2], ot[dt][3]));
  __syncthreads();
}

DEV void attn_sample_item(const Params& P, int l, int sb, int h, char* smem) {
  float* sc = (float*)smem;
  float* so = (float*)(smem + 1024);
  const int tid = tidx(), lane = tid & 63, w = tid >> 6;
  const int R = TP + sb;
  const u16* qp = P.qb + (size_t)R * DM + h * 256 + lane * 4;
  uint2 qraw = *(const uint2*)qp;
  float q0 = bf2f((u16)(qraw.x & 0xffff)), q1 = bf2f((u16)(qraw.x >> 16)), q2 = bf2f((u16)(qraw.y & 0xffff)), q3 = bf2f((u16)(qraw.y >> 16));
  const float* kp = P.in[I_CK] + ((size_t)(l * 128 + sb) * 256) * 1024 + h * 256 + lane * 4;
  const float* vp = P.in[I_CV] + ((size_t)(l * 128 + sb) * 256) * 1024 + h * 256 + lane * 4;
  __syncthreads();
  for (int m0 = 0; m0 < 64; m0 += 8) {
    f32x4 kv[8];
#pragma unroll
    for (int j = 0; j < 8; j++) kv[j] = __builtin_nontemporal_load((const f32x4*)(kp + (size_t)(w * 64 + m0 + j) * 1024));
#pragma unroll
    for (int j = 0; j < 8; j++) {
      float d = wave_sum(kv[j][0] * q0 + kv[j][1] * q1 + kv[j][2] * q2 + kv[j][3] * q3);
      if (lane == 0) sc[w * 64 + m0 + j] = d;
    }
  }
  __syncthreads();
  float4 s4 = *(const float4*)(sc + lane * 4);
  float mx = fmaxf(fmaxf(s4.x, s4.y), fmaxf(s4.z, s4.w));
#pragma unroll
  for (int o = 1; o < 64; o <<= 1) mx = fmaxf(mx, __shfl_xor(mx, o));
  float sum = wave_sum(__expf(s4.x - mx) + __expf(s4.y - mx) + __expf(s4.z - mx) + __expf(s4.w - mx));
  const float inv = 1.f / sum;
  float4 acc = make_float4(0.f, 0.f, 0.f, 0.f);
  for (int m0 = 0; m0 < 64; m0 += 8) {
    f32x4 vv[8];
#pragma unroll
    for (int j = 0; j < 8; j++) vv[j] = __builtin_nontemporal_load((const f32x4*)(vp + (size_t)(w * 64 + m0 + j) * 1024));
#pragma unroll
    for (int j = 0; j < 8; j++) {
      float p = __expf(sc[w * 64 + m0 + j] - mx) * inv;
      acc.x = fmaf(p, vv[j][0], acc.x); acc.y = fmaf(p, vv[j][1], acc.y); acc.z = fmaf(p, vv[j][2], acc.z); acc.w = fmaf(p, vv[j][3], acc.w);
    }
  }
  *(float4*)(so + w * 256 + lane * 4) = acc;
  __syncthreads();
  {
    float o = so[tid] + so[256 + tid] + so[512 + tid] + so[768 + tid];
    P.ao[(size_t)R * DM + h * 256 + tid] = f2bf(o);
  }
  __syncthreads();
}

DEV void phase_attn(const Params& P, int l, char* smem) {
  if (gridDim.x == 512) {
    const int B = blockIdx.x, x = B & 7, bl = B >> 3;
    const bool sfirst = (bl & 1);
    for (int s3 = 0; s3 < 3; s3++) {
      const int k = sfirst ? (s3 + 2) % 3 : s3;
      if (k < 2) {
        const int g = k * 16 + x * 2 + (bl >> 5);
        attn_prompt_item(P, l, g >> 2, g & 3, bl & 31, smem);
      } else {
        attn_sample_item(P, l, B >> 2, B & 3, smem);
      }
    }
    return;
  }
  const bool sfirst = ((1024 % gridDim.x) == 0) && ((blockIdx.x >> 3) & 1);
  for (int it0 = blockIdx.x; it0 < 1536; it0 += gridDim.x) {
    const int it = sfirst ? ((it0 + 1024) % 1536) : it0;
    if (it < 1024) attn_prompt_item(P, l, it >> 7, (it >> 5) & 3, it & 31, smem);
    else attn_sample_item(P, l, (it - 1024) >> 2, (it - 1024) & 3, smem);
  }
}

constexpr int N_PHASES = 27;
#ifndef PH_MASK
#define PH_MASK 0xffffu
#endif

DEV void run_stage(const Params& P, int l, int s, char* smem, int cu_slot) {
  if (s == 13) { if (PH_MASK & 0x2000u) phase_prep(P, smem); return; }
  if (!((PH_MASK >> s) & 1u)) return;
  switch (s) {
    case 0:
      if (!(PH_MASK & 1u)) break;
      gemm_phase(P, EP_PROJ, l, P.xb, DM, P.wt + l * W_LAYER + WO_IN, DM, DM, TT / 128, PRJ / 128, smem);
      if (l == 0) {
        const int nb = gridDim.x;
        if ((nb & 7) == 0) {
          const int x = blockIdx.x & 7, bl = blockIdx.x >> 3, per = nb >> 3;
          for (int v = per - 1 - bl; v < 64; v += per) {
            if (v < 0) continue;
            const int u = x * 64 + v;
            const int ll = u >> 8, kv = (u >> 7) & 1, t = u & 127;
            gemm_tile<4>(P, kv ? EP_MEMV : EP_MEMK, ll, P.memb, DM, P.wt + ll * W_LAYER + (kv ? WO_XV : WO_XK), DM, DM,
                         (t >> 3) * 128, (t & 7) * 128, smem);
          }
        } else {
          for (int u = blockIdx.x; u < 512; u += nb) {
            const int ll = u >> 8, kv = (u >> 7) & 1, t = u & 127;
            gemm_tile<4>(P, kv ? EP_MEMV : EP_MEMK, ll, P.memb, DM, P.wt + ll * W_LAYER + (kv ? WO_XV : WO_XK), DM, DM,
                         (t >> 3) * 128, (t & 7) * 128, smem);
          }
        }
      }
      break;
    case 1: if (!(PH_MASK & 2u)) break; phase_dprep(P, l, smem); break;
    case 2: {
      if (!(PH_MASK & 4u)) break;
      const int nb = gridDim.x, bid = blockIdx.x;
      if (nb >= 256 && ((nb - 128) & 3) == 0) {
        if (bid < 128) phase_scan(P, l, smem, cu_slot, bid, nb, 0, 0);
        else {
          phase_scan(P, l, smem, cu_slot, 0, 0, bid - 128, nb - 128);
          phase_mixer_rest(P, l, smem, bid - 128, nb - 128);
        }
      } else {
        phase_scan(P, l, smem, cu_slot, bid, nb, nb - 1 - bid, nb);
        phase_mixer_rest(P, l, smem, bid, nb);
      }
    } break;
    case 3: if (!(PH_MASK & 8u)) break; phase_dpost(P, l); break;
    case 4: if (!(PH_MASK & 16u)) break; gemm_phase(P, EP_RES, l, P.mix, DM, P.wt + l * W_LAYER + WO_OUT, DM, DM, TT / 128, 8, smem, 1); break;
    case 5: if (!(PH_MASK & 32u)) break; phase_ln(P, P.in[I_LN1G] + l * DM, P.in[I_LN1B] + l * DM, P.hf); break;
    case 6: if (!(PH_MASK & 64u)) break; gemm_phase(P, EP_Q, l, P.xb, DM, P.wt + l * W_LAYER + WO_XQ, DM, DM, TT / 128, 8, smem, 1); break;
    case 7: if (!(PH_MASK & 128u)) break; phase_attn(P, l, smem); break;
    case 8: if (!(PH_MASK & 256u)) break; gemm_phase(P, EP_RES, l, P.ao, DM, P.wt + l * W_LAYER + WO_XO, DM, DM, TT / 128, 8, smem, 1); break;
    case 9: if (!(PH_MASK & 512u)) break; phase_ln(P, P.in[I_LN2G] + l * DM, P.in[I_LN2B] + l * DM, P.hf); break;
    case 10: if (!(PH_MASK & 1024u)) break; gemm_phase(P, EP_FFN1, l, P.xb, DM, P.wt + l * W_LAYER + WO_13, DM, DM, TT / 128, (2 * DFF) / 128, smem); break;
    case 11: if (!(PH_MASK & 2048u)) break; gemm_phase(P, EP_RES, l, P.ffh, DFF, P.wt + l * W_LAYER + WO_2, DFF, DFF, TT / 128, 8, smem, 1); break;
    case 12: if (!(PH_MASK & 4096u)) break; phase_ln(P, P.in[I_LN3G] + l * DM, P.in[I_LN3B] + l * DM, (l == 1) ? P.out : P.hf); break;
  }
}


#define XB_TMO      128
#define XB_XCNT(j)  (256  + 64 * (j))
#define XB_XSUB(j)  (1280 + 64 * (j))
#define XB_XGEN(j)  (2304 + 64 * (j))
#define XB_TOP      3328
#define XB_TOPGEN   3392
#define XCD_BAR_WORDS 3456
#define XB_SPIN_CAP (1u << 23)
#define LAS __attribute__((address_space(3)))
DEV unsigned xb_ld(unsigned* p) { return __hip_atomic_load(p, __ATOMIC_RELAXED, __HIP_MEMORY_SCOPE_AGENT); }
DEV unsigned xb_add(unsigned* p, unsigned v) { return __hip_atomic_fetch_add(p, v, __ATOMIC_RELAXED, __HIP_MEMORY_SCOPE_AGENT); }
DEV unsigned xb_xcc_id() { return (unsigned)__builtin_amdgcn_s_getreg((3 << 11) | 20) & 0xFu; }
#define XB_SPIN(cond, bar) do { unsigned _sp = 0; while (cond) { __builtin_amdgcn_s_sleep(1); \
    if ((++_sp & 255u) == 0u) { if (xb_ld(&(bar)[XB_TMO])) break; if (_sp > XB_SPIN_CAP) { atomicAdd(&(bar)[XB_TMO], 1u); break; } } } } while (0)
struct XcdBarrier { unsigned* bar; unsigned x; volatile LAS unsigned* st; };
DEV XcdBarrier xcd_barrier_post(unsigned* bar, volatile LAS unsigned* st) {
  XcdBarrier b; b.bar = bar; b.x = xb_xcc_id(); b.st = st;
  if (threadIdx.x == 0) (void)xb_add(&bar[XB_XCNT(b.x)], 1u);
  return b;
}
DEV void xcd_barrier_complete(unsigned* bar, unsigned x, unsigned& nloc, unsigned& nx) {
  const unsigned G = gridDim.x * gridDim.y * gridDim.z;
  unsigned sum, cnt, mine, sp = 0u;
  for (;;) {
    sum = 0u; cnt = 0u; mine = 0u;
#pragma unroll
    for (unsigned j = 0; j < 16; ++j) { const unsigned c = xb_ld(&bar[XB_XCNT(j)]); sum += c; cnt += (c > 0u) ? 1u : 0u; mine = (j == x) ? c : mine; }
    if (sum == G) break;
    __builtin_amdgcn_s_sleep(1);
    if ((++sp & 255u) == 0u) { if (xb_ld(&bar[XB_TMO])) break; if (sp > XB_SPIN_CAP) { atomicAdd(&bar[XB_TMO], 1u); break; } }
  }
  nloc = mine > 0u ? mine : 1u; nx = cnt > 0u ? cnt : 1u;
}
DEV void xcd_barrier(const XcdBarrier& b) {
  asm volatile("s_waitcnt vmcnt(0)" ::: "memory");
  __syncthreads();
  if (threadIdx.x == 0) {
    unsigned* bar = b.bar;
    __builtin_amdgcn_s_waitcnt(0);
    unsigned nloc = b.st[0], nx = b.st[1];
    if (nloc == 0u) { xcd_barrier_complete(bar, b.x, nloc, nx); b.st[0] = nloc; b.st[1] = nx; }
    const unsigned old = xb_add(&bar[XB_XSUB(b.x)], 1u);
    const unsigned gen = old / nloc;
    if (old + 1u == (gen + 1u) * nloc) {
      __builtin_amdgcn_fence(__ATOMIC_RELEASE, "agent");
      asm volatile("s_waitcnt vmcnt(0)" ::: "memory");
      const unsigned og = xb_add(&bar[XB_TOP], 1u);
      const unsigned tg = og / nx;
      if (og + 1u == (tg + 1u) * nx) xb_add(&bar[XB_TOPGEN], 1u);
      else XB_SPIN(xb_ld(&bar[XB_TOPGEN]) == tg, bar);
      __builtin_amdgcn_fence(__ATOMIC_ACQUIRE, "agent");
      xb_add(&bar[XB_XGEN(b.x)], 1u);
      asm volatile("s_waitcnt vmcnt(0)" ::: "memory");
    } else {
      XB_SPIN(xb_ld(&bar[XB_XGEN(b.x)]) == gen, bar);
      __builtin_amdgcn_fence(__ATOMIC_ACQUIRE, "agent");
      asm volatile("s_waitcnt vmcnt(0)" ::: "memory");
    }
  }
  __syncthreads();
}

#ifndef REPEAT_MASK
#define REPEAT_MASK 0u
#endif
__global__ void __launch_bounds__(256, 2) mega_coop(Params P) {
  __shared__ __attribute__((aligned(16))) char smem[65536];
  __shared__ uint4 xb_words;
  if (threadIdx.x == 0) xb_words = make_uint4(0u, 0u, 0u, 0u);
  __syncthreads();
  XcdBarrier xb = xcd_barrier_post(P.bar, (volatile LAS unsigned*)&xb_words);
  __shared__ int cu_slot_s;
  if (threadIdx.x == 0) {
    const unsigned hw = (unsigned)__builtin_amdgcn_s_getreg((7 << 11) | (8 << 6) | 4);
    const unsigned key = ((xb.x & 15u) << 8) | (hw & 255u);
    cu_slot_s = (int)atomicAdd(&P.bar[XB_CUTAB + key], 1u);
  }
  __syncthreads();
  const int cu_slot = cu_slot_s;
  if (P.out == nullptr) cg::this_grid().sync();
  run_stage(P, 0, 13, smem, cu_slot);
  for (int ph = 0; ph < 26; ph++) {
    xcd_barrier(xb);
    run_stage(P, ph / 13, ph % 13, smem, cu_slot);
    if ((REPEAT_MASK >> (ph % 13)) & 1u) { xcd_barrier(xb); run_stage(P, ph / 13, ph % 13, smem, cu_slot); }
  }
}

__global__ void __launch_bounds__(256, 2) mega_range(Params P, int ph_lo, int ph_hi) {
  __shared__ __attribute__((aligned(16))) char smem[65536];
  const int cu_slot = blockIdx.x & 1;
  if (ph_lo < 0) { run_stage(P, 0, 13, smem, cu_slot); ph_lo = 0; }
  for (int ph = ph_lo; ph < ph_hi; ph++) {
    if (ph > ph_lo) __syncthreads();
    run_stage(P, ph / 13, ph % 13, smem, cu_slot);
  }
}

#ifndef USE_COOP
#define USE_COOP 1
#endif

extern "C" void kernel_launch(void* const* d_in, const int* in_sizes, int n_in, void* d_out, int out_size, void* d_ws, size_t ws_size,
                              hipStream_t stream) {
  Params P{};
  for (int i = 0; i < 42; i++) P.in[i] = (const float*)d_in[i];
  P.out = (float*)d_out;
  char* ws = (char*)d_ws;
  size_t off = 0;
  auto take = [&](size_t bytes) { char* p = ws + off; off += (bytes + 255) & ~(size_t)255; return p; };
  P.wt = (u16*)take((size_t)2 * W_LAYER * 2);
  P.xb = (u16*)take((size_t)TT * DM * 2);
  P.hf = (float*)take((size_t)TT * DM * 4);
  P.proj = (float*)take((size_t)TT * PRJ * 4);
  P.mix = (u16*)take((size_t)TT * DM * 2);
  P.pre = (float*)take((size_t)TT * DM * 4);
  P.qb = (u16*)take((size_t)TT * DM * 2);
  P.ao = (u16*)take((size_t)TT * DM * 2);
  P.ffh = (u16*)take((size_t)TT * DFF * 2);
  P.scanin = (float*)take((size_t)TT * 4 * 384 * 4);
  P.obuf = (float*)take((size_t)TT * 256 * 4);
  P.gbuf = (float*)take((size_t)TT * 256 * 4);
  P.memb = (u16*)take((size_t)2048 * DM * 2);
  P.kb = (u16*)take((size_t)2 * 2048 * DM * 2);
  P.vtb = (u16*)take((size_t)2 * 2048 * DM * 2);
  P.bar = (unsigned*)take((size_t)XB_TOTAL_WORDS * 4);
  if (off > ws_size) { fprintf(stderr, "workspace too small: need %zu have %zu\n", off, ws_size); return; }

  static int grid_blocks = 0;
  if (!grid_blocks) {
    int dev = 0, cus = 0, per_cu = 0;
    hipGetDevice(&dev);
    hipDeviceGetAttribute(&cus, hipDeviceAttributeMultiprocessorCount, dev);
    hipOccupancyMaxActiveBlocksPerMultiprocessor(&per_cu, mega_coop, 256, 0);
    if (per_cu > 2) per_cu = 2;
    if (per_cu < 1) per_cu = 1;
    grid_blocks = cus * per_cu;
  }
  (void)hipMemsetAsync(P.bar, 0, (size_t)XB_TOTAL_WORDS * 4, stream);
#if USE_COOP
  void* args[] = {&P};
  hipError_t e = hipLaunchCooperativeKernel((void*)mega_coop, dim3(grid_blocks), dim3(256), args, 0, stream);
  if (e != hipSuccess) fprintf(stderr, "cooperative launch failed: %s (grid %d)\n", hipGetErrorString(e), grid_blocks);
#else
  mega_range<<<grid_blocks, 256, 0, stream>>>(P, -1, 0);
  for (int ph = 0; ph < 26; ph++) mega_range<<<grid_blocks, 256, 0, stream>>>(P, ph, ph + 1);
#endif
}
```

```cpp
#include <hip/hip_runtime.h>
#include <hip/hip_cooperative_groups.h>
#include <cstdio>
namespace cg = cooperative_groups;

typedef unsigned short u16;
typedef __attribute__((ext_vector_type(8))) short bf16x8;
typedef __attribute__((ext_vector_type(4))) float f32x4;
typedef __attribute__((ext_vector_type(4))) unsigned u32x4;
#define DEV __device__ __forceinline__

constexpr int TP = 16384, TS = 128, TT = 16512, DM = 1024, PRJ = 2432, DFF = 2816;
constexpr float ALPHA = 1.41421356237309515f;
#define XB_CUTAB 3456
#define XB_JOBCTR(l) (3456 + 4096 + 64 * (l))
#define XB_TOTAL_WORDS (3456 + 4096 + 128)
constexpr size_t O_YP = 0;
constexpr size_t O_YS = O_YP + (size_t)TP * DM;
constexpr size_t O_CVP = O_YS + (size_t)TS * DM;
constexpr size_t O_PLP = O_CVP + 2 * 8 * 128 * 256;
constexpr size_t O_CNP = O_PLP + 2 * 8 * 15 * 256;
constexpr size_t O_SHP = O_CNP + 2 * 8 * 2 * 256;
constexpr size_t O_WKP = O_SHP + 2 * 8 * 896;
constexpr size_t O_MKP = O_WKP + 2 * 8 * 4 * 64 * 64;
constexpr size_t O_MVP = O_MKP + 2 * 8 * 256 * 1024;
constexpr size_t O_CVS = O_MVP + 2 * 8 * 256 * 1024;
constexpr size_t O_PLS = O_CVS + 2 * 128 * 256;
constexpr size_t O_CNS = O_PLS + 2 * 128 * 15 * 256;
constexpr size_t O_SHS = O_CNS + 2 * 128 * 2 * 256;
constexpr size_t O_WKS = O_SHS + 2 * 128 * 896;


constexpr size_t WO_IN = 0;
constexpr size_t WO_OUT = WO_IN + (size_t)PRJ * DM;
constexpr size_t WO_XQ = WO_OUT + (size_t)DM * DM;
constexpr size_t WO_XK = WO_XQ + (size_t)DM * DM;
constexpr size_t WO_XV = WO_XK + (size_t)DM * DM;
constexpr size_t WO_XO = WO_XV + (size_t)DM * DM;
constexpr size_t WO_13 = WO_XO + (size_t)DM * DM;
constexpr size_t WO_2 = WO_13 + (size_t)2 * DFF * DM;
constexpr size_t W_LAYER = WO_2 + (size_t)DM * DFF;

enum { I_XP = 0, I_XS, I_MEM, I_CK, I_CV, I_SPOOL, I_SCONV, I_SSHIFT, I_SWKV, I_WIN, I_MUD, I_LNVG, I_LNVB, I_WSC, I_BCH,
       I_WPOOL, I_PSCALE, I_CONVW, I_W0, I_W2, I_A0, I_A2, I_G2, I_KK, I_KA, I_RK, I_LNXG, I_LNXB, I_WOUT, I_LN1G, I_LN1B,
       I_WXQ, I_WXK, I_WXV, I_WXO, I_LN2G, I_LN2B, I_FW1, I_FW3, I_FW2, I_LN3G, I_LN3B };

struct Params {
  const float* in[42];
  float* out;
  u16* wt;
  u16* xb; float* hf; float* proj; u16* mix; float* pre; u16* qb; u16* ao; u16* ffh;
  float* scanin; float* obuf; float* gbuf; u16* memb; u16* kb; u16* vtb;
  unsigned* bar;
};

DEV int tidx() { int t = (int)__builtin_amdgcn_workitem_id_x(); asm volatile("" : "+v"(t)); return t; }
DEV u16 f2bf(float f) {
  unsigned u = __float_as_uint(f);
  u += 0x7fffu + ((u >> 16) & 1u);
  return (u16)(u >> 16);
}
DEV unsigned pack2(float a, float b) { return (unsigned)f2bf(a) | ((unsigned)f2bf(b) << 16); }
DEV float bf2f(u16 h) { return __uint_as_float(((unsigned)h) << 16); }
DEV float frcp(float x) { return __builtin_amdgcn_rcpf(x); }
DEV float ftanh(float x) {
  float e = __expf(2.f * fminf(fmaxf(x, -15.f), 15.f));
  return (e - 1.f) * frcp(e + 1.f);
}
DEV float gelu_t(float x) { return 0.5f * x * (1.f + ftanh(0.7978845608028654f * (x + 0.044715f * x * x * x))); }
DEV float sigm(float x) { return frcp(1.f + __expf(-x)); }
DEV float softplus(float x) { return fmaxf(x, 0.f) + __logf(1.f + __expf(-fabsf(x))); }

template <int CTRL> DEV float dpp_mov(float x) {
  return __int_as_float(__builtin_amdgcn_update_dpp(0, __float_as_int(x), CTRL, 0xf, 0xf, false));
}
DEV float row16_sum(float x) {
  x += dpp_mov<0xB1>(x);
  x += dpp_mov<0x4E>(x);
  x += dpp_mov<0x141>(x);
  x += dpp_mov<0x140>(x);
  return x;
}
DEV float wave_sum(float x) {
  x = row16_sum(x);
  x += __shfl_xor(x, 16);
  x += __shfl_xor(x, 32);
  return x;
}

enum { EP_PROJ = 0, EP_RES, EP_Q, EP_FFN1, EP_MEMK, EP_MEMV };

template <int NJ>
DEV void gemm_tile(const Params& P, int mode, int l, const u16* __restrict__ A, int lda, const u16* __restrict__ Bt, int ldb,
                   int K, int row0, int col0, char* smem) {
  u16* sA0 = (u16*)smem;
  u16* sB0 = (u16*)(smem + 16384);
  u16* sA1 = (u16*)(smem + 32768);
  u16* sB1 = (u16*)(smem + 49152);
  const int tid = tidx(), lane = tid & 63, wave = tid >> 6;
  const int wm = wave >> 1, wn = wave & 1;
  const int fr = lane & 15, fq = lane >> 4;
  const int lr = tid >> 3, ls = tid & 7;
  const u16* Ag = A + (size_t)(row0 + lr) * lda + ls * 8;
  const u16* Bg = Bt + (size_t)(col0 + lr) * ldb + ls * 8;
  const int woff = lr * 64 + ((ls ^ (lr & 7)) * 8);
  f32x4 acc[4][4];
#pragma unroll
  for (int i = 0; i < 4; i++)
#pragma unroll
    for (int j = 0; j < 4; j++) acc[i][j] = (f32x4){0.f, 0.f, 0.f, 0.f};
  u32x4 ga0[4], gb0[4], ga1[4], gb1[4];
#define G_LOAD(RA, RB, KT)                                                      \
  _Pragma("unroll") for (int i = 0; i < 4; i++) {                               \
    RA[i] = *(const u32x4*)(Ag + (size_t)(i * 32) * lda + (KT) * 64);           \
    if (i < NJ) RB[i] = *(const u32x4*)(Bg + (size_t)(i * 32) * ldb + (KT) * 64); \
  }
#define L_STORE(SA, SB, RA, RB)                                                 \
  _Pragma("unroll") for (int i = 0; i < 4; i++) {                               \
    *(u32x4*)(SA + woff + i * 2048) = RA[i];                                    \
    if (i < NJ) *(u32x4*)(SB + woff + i * 2048) = RB[i];                        \
  }
#define G_READ(SA, SB)                                                          \
  _Pragma("unroll") for (int ks = 0; ks < 2; ks++) {                            \
    const int slot = ks * 4 + fq;                                               \
    {                                                                           \
      int row = wm * 64 + fr;                                                   \
      af[ks][0] = *(const bf16x8*)(SA + row * 64 + ((slot ^ (row & 7)) * 8));   \
    }                                                                           \
    _Pragma("unroll") for (int j = 0; j < NJ; j++) {                            \
      int row = wn * (NJ * 16) + j * 16 + fr;                                   \
      bfr[ks][j] = *(const bf16x8*)(SB + row * 64 + ((slot ^ (row & 7)) * 8));  \
    }                                                                           \
    _Pragma("unroll") for (int i = 1; i < 4; i++) {                             \
      int row = wm * 64 + i * 16 + fr;                                          \
      af[ks][i] = *(const bf16x8*)(SA + row * 64 + ((slot ^ (row & 7)) * 8));   \
    }                                                                           \
  }
#define G_MMA                                                                   \
  _Pragma("unroll") for (int ks = 0; ks < 2; ks++)                              \
    _Pragma("unroll") for (int i = 0; i < 4; i++)                               \
      _Pragma("unroll") for (int j = 0; j < NJ; j++)                            \
        acc[i][j] = __builtin_amdgcn_mfma_f32_16x16x32_bf16(af[ks][i], bfr[ks][j], acc[i][j], 0, 0, 0);
#define G_SCHED                                                                 \
  if (NJ == 4) {                                                                \
    __builtin_amdgcn_sched_group_barrier(0x100, 2, 0);                          \
    _Pragma("unroll") for (int q_ = 0; q_ < 14; q_++) {                         \
      __builtin_amdgcn_sched_group_barrier(0x008, 1, 0);                        \
      __builtin_amdgcn_sched_group_barrier(0x100, 1, 0);                        \
    }                                                                           \
    __builtin_amdgcn_sched_group_barrier(0x008, 2, 0);                          \
    _Pragma("unroll") for (int q_ = 0; q_ < 8; q_++) {                          \
      __builtin_amdgcn_sched_group_barrier(0x008, 2, 0);                        \
      __builtin_amdgcn_sched_group_barrier(0x200, 1, 0);                        \
      __builtin_amdgcn_sched_group_barrier(0x020, 1, 0);                        \
    }                                                                           \
  }
  bf16x8 af[2][4], bfr[2][4];
  const int nk = K >> 6;
  __syncthreads();
  G_LOAD(ga0, gb0, 0)
  G_LOAD(ga1, gb1, 1)
  L_STORE(sA0, sB0, ga0, gb0)
  G_LOAD(ga0, gb0, 2)
  __syncthreads();
  for (int kt = 0; kt < nk; kt += 2) {
    G_READ(sA0, sB0)
    L_STORE(sA1, sB1, ga1, gb1)
    { const int k3 = min(kt + 3, nk - 1); G_LOAD(ga1, gb1, k3) }
    G_MMA
    G_SCHED
    __syncthreads();
    G_READ(sA1, sB1)
    L_STORE(sA0, sB0, ga0, gb0)
    { const int k4 = min(kt + 4, nk - 1); G_LOAD(ga0, gb0, k4) }
    G_MMA
    G_SCHED
    __syncthreads();
  }
#undef G_LOAD
#undef L_STORE
#undef G_READ
#undef G_MMA
#undef G_SCHED
  const int rb0 = row0 + wm * 64 + fq * 4;
  const int cb0 = col0 + wn * (NJ * 16) + fr;
  if (NJ == 4 && mode == EP_PROJ) {
#pragma unroll
    for (int i = 0; i < 4; i++)
#pragma unroll
      for (int e = 0; e < 4; e++) {
        int row = rb0 + i * 16 + e;
#pragma unroll
        for (int j = 0; j < 4; j++) {
          int col = cb0 + j * 16;
          float v = acc[i][j][e];
          if (col < 512) v = gelu_t(v);
          P.proj[(size_t)row * PRJ + col] = v;
        }
      }
  } else if (mode == EP_RES) {
    float hv[4][4][4];
#pragma unroll
    for (int i = 0; i < 4; i++)
#pragma unroll
      for (int e = 0; e < 4; e++)
#pragma unroll
        for (int j = 0; j < NJ; j++) hv[i][e][j] = P.hf[(size_t)(rb0 + i * 16 + e) * DM + cb0 + j * 16];
#pragma unroll
    for (int i = 0; i < 4; i++)
#pragma unroll
      for (int e = 0; e < 4; e++)
#pragma unroll
        for (int j = 0; j < NJ; j++) P.pre[(size_t)(rb0 + i * 16 + e) * DM + cb0 + j * 16] = ALPHA * hv[i][e][j] + acc[i][j][e];
  } else if (mode == EP_Q) {
#pragma unroll
    for (int i = 0; i < 4; i++)
#pragma unroll
      for (int e = 0; e < 4; e++) {
        int row = rb0 + i * 16 + e;
#pragma unroll
        for (int j = 0; j < NJ; j++) {
          int col = cb0 + j * 16;
          P.qb[(size_t)row * DM + col] = f2bf(acc[i][j][e] * 0.0625f);
        }
      }
  } else if (NJ == 4 && mode == EP_FFN1) {
    const int oc0 = ((col0 + wn * 64) >> 1) + fr;
#pragma unroll
    for (int i = 0; i < 4; i++)
#pragma unroll
      for (int e = 0; e < 4; e++) {
        int row = rb0 + i * 16 + e;
#pragma unroll
        for (int j = 0; j < 2; j++) {
          float a = acc[i][j][e], b = acc[i][j + 2][e];
          float v = a * sigm(a) * b;
          P.ffh[(size_t)row * DFF + oc0 + j * 16] = f2bf(v);
        }
      }
  } else if (NJ == 4 && mode == EP_MEMK) {
    float* ok = P.out + O_MKP + (size_t)l * 2048 * 1024;
    u16* kb = P.kb + (size_t)l * 2048 * 1024;
#pragma unroll
    for (int i = 0; i < 4; i++)
#pragma unroll
      for (int e = 0; e < 4; e++) {
        int row = rb0 + i * 16 + e;
#pragma unroll
        for (int j = 0; j < 4; j++) {
          int col = cb0 + j * 16;
          float v = acc[i][j][e];
          ok[(size_t)row * DM + col] = v;
          kb[(size_t)row * DM + col] = f2bf(v);
        }
      }
  } else if (NJ == 4) {
    float* ov = P.out + O_MVP + (size_t)l * 2048 * 1024;
#pragma unroll
    for (int i = 0; i < 4; i++) {
      int row = rb0 + i * 16;
      int b = row >> 8, m = row & 255;
#pragma unroll
      for (int j = 0; j < 4; j++) {
        int col = cb0 + j * 16;
#pragma unroll
        for (int e = 0; e < 4; e++) ov[(size_t)(row + e) * DM + col] = acc[i][j][e];
        uint2 pk;
        pk.x = pack2(acc[i][j][0], acc[i][j][1]);
        pk.y = pack2(acc[i][j][2], acc[i][j][3]);
        *(uint2*)(P.vtb + ((size_t)(l * 8 + b) * 1024 + col) * 256 + m) = pk;
      }
    }
  }
}

DEV void tile_map(int t, int mtiles, int ntiles, int& mt, int& nt) {
  const int g = t / (8 * ntiles);
  int r = t - g * 8 * ntiles;
  const int rows = min(8, mtiles - 8 * g);
  int p = 0;
  if (rows == 8) { p = r >> 6; r -= p << 6; }
  else { const int per = rows * 8; p = r / per; r -= p * per; }
  const int pc = min(8, ntiles - 8 * p);
  (void)pc;
  const int ml = r % rows, nl = r / rows;
  mt = 8 * g + ml;
  nt = 8 * p + nl;
}

DEV void gemm_phase(const Params& P, int mode, int l, const u16* A, int lda, const u16* Bt, int ldb, int K, int mtiles, int ntiles,
                    char* smem, int split = 0) {
  const int mm = split ? mtiles - 1 : mtiles;
  const int total = mm * ntiles;
  const int nb = gridDim.x;
  if ((nb & 7) == 0) {
    const int x = blockIdx.x & 7, bl = blockIdx.x >> 3, per = nb >> 3;
    const int Q = (total + 7) >> 3;
    for (int li = bl; li < Q; li += per) {
      int t = x * Q + li;
      if (t >= total) break;
      int mt, nt;
      tile_map(t, mm, ntiles, mt, nt);
      gemm_tile<4>(P, mode, l, A, lda, Bt, ldb, K, mt * 128, nt * 128, smem);
    }
  } else {
    for (int t = blockIdx.x; t < total; t += nb) {
      int mt, nt;
      tile_map(t, mm, ntiles, mt, nt);
      gemm_tile<4>(P, mode, l, A, lda, Bt, ldb, K, mt * 128, nt * 128, smem);
    }
  }
  if (split) {
    const int vbk = (nb & 7) == 0 ? ((blockIdx.x >> 3) * 8 + (blockIdx.x & 7)) : blockIdx.x;
    for (int ht = vbk; ht < 2 * ntiles; ht += nb) gemm_tile<2>(P, mode, l, A, lda, Bt, ldb, K, mm * 128, ht * 64, smem);
  }
}

DEV void transpose_tile(const float* __restrict__ src, int K, int N, u16* __restrict__ dst, int mode, int kt, int nt, float* sT) {
  const int tid = tidx();
  const int r = tid >> 4, c4 = (tid & 15) * 4;
#pragma unroll
  for (int i = 0; i < 4; i++) {
    int rr = r + 16 * i;
    float4 v = *(const float4*)(src + (size_t)(kt * 64 + rr) * N + nt * 64 + c4);
    sT[rr * 65 + c4 + 0] = v.x;
    sT[rr * 65 + c4 + 1] = v.y;
    sT[rr * 65 + c4 + 2] = v.z;
    sT[rr * 65 + c4 + 3] = v.w;
  }
  __syncthreads();
  const int n = tid >> 2, kseg = (tid & 3) * 16;
  unsigned pk[8];
#pragma unroll
  for (int j = 0; j < 8; j++) pk[j] = pack2(sT[(kseg + 2 * j) * 65 + n], sT[(kseg + 2 * j + 1) * 65 + n]);
  const int ncol = nt * 64 + n;
  const int drow = (mode == 0) ? ncol : ((ncol >> 5) * 64 + (mode == 2 ? 32 : 0) + (ncol & 31));
  u16* d = dst + (size_t)drow * K + kt * 64 + kseg;
  *(uint4*)(d) = make_uint4(pk[0], pk[1], pk[2], pk[3]);
  *(uint4*)(d + 8) = make_uint4(pk[4], pk[5], pk[6], pk[7]);
  __syncthreads();
}

DEV void phase_prep(const Params& P, char* smem) {
  float* sT = (float*)smem;
  for (int it = blockIdx.x; it < 8000; it += gridDim.x) {
    int l = it / 4000, r = it - l * 4000;
    const float* src; u16* dst; int K, N, mode = 0, idx;
    if (r < 608) { idx = r; src = P.in[I_WIN] + (size_t)l * 1024 * 2432; dst = P.wt + l * W_LAYER + WO_IN; K = 1024; N = 2432; }
    else if (r < 864) { idx = r - 608; src = P.in[I_WOUT] + (size_t)l * 1048576; dst = P.wt + l * W_LAYER + WO_OUT; K = 1024; N = 1024; }
    else if (r < 1120) { idx = r - 864; src = P.in[I_WXQ] + (size_t)l * 1048576; dst = P.wt + l * W_LAYER + WO_XQ; K = 1024; N = 1024; }
    else if (r < 1376) { idx = r - 1120; src = P.in[I_WXK] + (size_t)l * 1048576; dst = P.wt + l * W_LAYER + WO_XK; K = 1024; N = 1024; }
    else if (r < 1632) { idx = r - 1376; src = P.in[I_WXV] + (size_t)l * 1048576; dst = P.wt + l * W_LAYER + WO_XV; K = 1024; N = 1024; }
    else if (r < 1888) { idx = r - 1632; src = P.in[I_WXO] + (size_t)l * 1048576; dst = P.wt + l * W_LAYER + WO_XO; K = 1024; N = 1024; }
    else if (r < 2592) { idx = r - 1888; src = P.in[I_FW1] + (size_t)l * 1024 * 2816; dst = P.wt + l * W_LAYER + WO_13; K = 1024; N = 2816; mode = 1; }
    else if (r < 3296) { idx = r - 2592; src = P.in[I_FW3] + (size_t)l * 1024 * 2816; dst = P.wt + l * W_LAYER + WO_13; K = 1024; N = 2816; mode = 2; }
    else { idx = r - 3296; src = P.in[I_FW2] + (size_t)l * 2816 * 1024; dst = P.wt + l * W_LAYER + WO_2; K = 2816; N = 1024; }
    int ntn = N >> 6;
    int kt = idx / ntn, nt = idx - kt * ntn;
    transpose_tile(src, K, N, dst, mode, kt, nt, sT);
  }
  const size_t gt = (size_t)blockIdx.x * blockDim.x + tidx(), gs = (size_t)gridDim.x * blockDim.x;
  {
    const size_t n4 = (size_t)TT * DM / 4, np4 = (size_t)TP * DM / 4;
    for (size_t i0 = gt; i0 < n4; i0 += 4 * gs) {
      float4 v[4];
#pragma unroll
      for (int u = 0; u < 4; u++) {
        size_t i = i0 + u * gs;
        if (i >= n4) i = i0;
        v[u] = (i < np4) ? ((const float4*)P.in[I_XP])[i] : ((const float4*)P.in[I_XS])[i - np4];
      }
#pragma unroll
      for (int u = 0; u < 4; u++) {
        size_t i = i0 + u * gs;
        if (i < n4) {
          ((float4*)P.hf)[i] = v[u];
          ((uint2*)P.xb)[i] = make_uint2(pack2(v[u].x, v[u].y), pack2(v[u].z, v[u].w));
        }
      }
    }
    const size_t m4 = (size_t)2048 * DM / 4;
    for (size_t i0 = gt; i0 < m4; i0 += 4 * gs) {
      float4 v[4];
#pragma unroll
      for (int u = 0; u < 4; u++) {
        size_t i = i0 + u * gs;
        if (i >= m4) i = i0;
        v[u] = ((const float4*)P.in[I_MEM])[i];
      }
#pragma unroll
      for (int u = 0; u < 4; u++) {
        size_t i = i0 + u * gs;
        if (i < m4) ((uint2*)P.memb)[i] = make_uint2(pack2(v[u].x, v[u].y), pack2(v[u].z, v[u].w));
      }
    }
  }
}

DEV float4 ln_v_row(const Params& P, int l, int R, int lane) {
  float4 x = *(const float4*)(P.proj + (size_t)R * PRJ + 256 + lane * 4);
  float mu = wave_sum(x.x + x.y + x.z + x.w) * (1.f / 256.f);
  float4 d = make_float4(x.x - mu, x.y - mu, x.z - mu, x.w - mu);
  float var = wave_sum(d.x * d.x + d.y * d.y + d.z * d.z + d.w * d.w) * (1.f / 256.f);
  float rs = rsqrtf(var + 1e-5f);
  float4 g = *(const float4*)(P.in[I_LNVG] + l * 256 + lane * 4);
  float4 b = *(const float4*)(P.in[I_LNVB] + l * 256 + lane * 4);
  return make_float4(d.x * rs * g.x + b.x, d.y * rs * g.y + b.y, d.z * rs * g.z + b.z, d.w * rs * g.w + b.w);
}

DEV void mixer_A_item(const Params& P, int l, int c, int h, char* smem) {
  float* sv = (float*)smem;
  const int tid = tidx(), lane = tid & 63;
  const int w = __builtin_amdgcn_readfirstlane(tid >> 6);
  const int R0 = c * 128, b = c >> 4, t0 = (c & 15) * 128;
#pragma unroll 4
  for (int rr = 0; rr < 32; rr++) {
    int row = w * 32 + rr;
    float4 vn = ln_v_row(P, l, R0 + row, lane);
    if ((lane >> 4) == h) *(float4*)(sv + row * 64 + (lane & 15) * 4) = vn;
  }
  __syncthreads();
  if (t0 == 1920) {
#pragma unroll
    for (int i = 0; i < 8; i++) {
      int idx = tid + i * 256;
      int row = idx >> 4, c4 = (idx & 15) * 4;
      *(float4*)(P.out + O_CVP + ((size_t)(l * 8 + b) * 128 + row) * 256 + h * 64 + c4) = *(const float4*)(sv + row * 64 + c4);
    }
  }
  float acc[32];
#pragma unroll
  for (int i = 0; i < 32; i++) acc[i] = 0.f;
  float* sw = (float*)(smem + 32768);
  const float* wsrc = P.in[I_WSC] + (size_t)(l * 4 + h) * 16384 + (tid >> 1) * 128 + (tid & 1) * 8;
  float* wdst = sw + (tid >> 1) * 16 + (tid & 1) * 8;
  float4 wa = *(const float4*)(wsrc), wb = *(const float4*)(wsrc + 4);
  *(float4*)(wdst) = wa;
  *(float4*)(wdst + 4) = wb;
  wa = *(const float4*)(wsrc + 16);
  wb = *(const float4*)(wsrc + 20);
  __syncthreads();
  for (int c8 = 0; c8 < 8; c8++) {
    const int s0 = c8 * 16;
    const float* cw = sw + (c8 & 1) * 2048;
    float vv[16];
#pragma unroll
    for (int j = 0; j < 16; j++) vv[j] = sv[(s0 + j) * 64 + lane];
#pragma unroll
    for (int i = 0; i < 32; i++) {
      const int t = 4 * i + w;
      if (t >= s0) {
        const float4 q0 = *(const float4*)(cw + t * 16), q1 = *(const float4*)(cw + t * 16 + 4);
        const float4 q2 = *(const float4*)(cw + t * 16 + 8), q3 = *(const float4*)(cw + t * 16 + 12);
        const float wr[16] = {q0.x, q0.y, q0.z, q0.w, q1.x, q1.y, q1.z, q1.w, q2.x, q2.y, q2.z, q2.w, q3.x, q3.y, q3.z, q3.w};
        if (t >= s0 + 15) {
#pragma unroll
          for (int j = 0; j < 16; j++) acc[i] = fmaf(wr[j], vv[j], acc[i]);
        } else {
#pragma unroll
          for (int j = 0; j < 16; j++) acc[i] = fmaf((s0 + j <= t) ? wr[j] : 0.f, vv[j], acc[i]);
        }
      }
    }
    {
      float* d2 = wdst + ((c8 + 1) & 1) * 2048;
      *(float4*)(d2) = wa;
      *(float4*)(d2 + 4) = wb;
      const int cn = min(c8 + 2, 7) * 16;
      wa = *(const float4*)(wsrc + cn);
      wb = *(const float4*)(wsrc + cn + 4);
    }
    __syncthreads();
  }
#pragma unroll
  for (int i0 = 0; i0 < 32; i0 += 16) {
    float uu[16];
#pragma unroll
    for (int i = 0; i < 16; i++) uu[i] = P.proj[(size_t)(R0 + 4 * (i0 + i) + w) * PRJ + h * 64 + lane];
#pragma unroll
    for (int i = 0; i < 16; i++) {
      const int t = 4 * (i0 + i) + w;
      float z = acc[i0 + i] + P.in[I_BCH][(l * 4 + h) * 128 + t];
      P.mix[(size_t)(R0 + t) * DM + h * 64 + lane] = f2bf(uu[i] * z);
    }
  }
  __syncthreads();
}

DEV void mixer_pool_item(const Params& P, int l, int sub, int gi, char* smem) {
  float* xs = (float*)smem;
  float* sd = (float*)(smem + 20480);
  const int tid = tidx(), lane = tid & 63, w = tid >> 6;
  const int R0 = sub * 64;
  const bool samp = (R0 >= TP);
  const int win = 2 << gi;
  if (!samp) {
    const int b = R0 >> 11, t0 = R0 & 2047;
    for (int idx = tid; idx < 79 * 16; idx += 256) {
      int rr = idx >> 4, c4 = (idx & 15) * 4;
      int t = t0 - 15 + rr;
      float4 v = make_float4(0.f, 0.f, 0.f, 0.f);
      if (t >= 0) v = *(const float4*)(P.proj + (size_t)(b * 2048 + t) * PRJ + 512 + gi * 64 + c4);
      *(float4*)(xs + rr * 64 + c4) = v;
    }
    __syncthreads();
    for (int idx = tid; idx < 4096; idx += 256) {
      int tt = idx >> 6, cc = idx & 63;
      float s = 0.f;
      for (int j = 0; j < win; j++) s += xs[(tt + 15 - j) * 64 + cc];
      int pos = t0 + tt;
      float cnt = (float)min(win, pos + 1);
      sd[tt * 64 + cc] = s / cnt - xs[(tt + 15) * 64 + cc];
    }
  } else {
    const int sb0 = R0 - TP;
    for (int idx = tid; idx < 4096; idx += 256) {
      int tt = idx >> 6, cc = idx & 63;
      int sb = sb0 + tt;
      float x = P.proj[(size_t)(TP + sb) * PRJ + 512 + gi * 64 + cc];
      float s = x;
      const float* st = P.in[I_SPOOL] + (size_t)(l * 128 + sb) * 15 * 256 + gi * 64 + cc;
      for (int q = 16 - win; q < 15; q++) s += st[q * 256];
      sd[tt * 64 + cc] = s / (float)win - x;
    }
  }
  __syncthreads();
  float acc[16];
#pragma unroll
  for (int i = 0; i < 16; i++) acc[i] = 0.f;
  const float* wp = P.in[I_WPOOL] + (size_t)(l * 4 + gi) * 4096 + lane;
#pragma unroll 4
  for (int c0 = 0; c0 < 64; c0 += 4) {
    float w0 = wp[(c0 + 0) * 64], w1 = wp[(c0 + 1) * 64], w2 = wp[(c0 + 2) * 64], w3 = wp[(c0 + 3) * 64];
#pragma unroll
    for (int i = 0; i < 16; i++) {
      float4 dd = *(const float4*)(sd + (w * 16 + i) * 64 + c0);
      acc[i] = fmaf(dd.x, w0, fmaf(dd.y, w1, fmaf(dd.z, w2, fmaf(dd.w, w3, acc[i]))));
    }
  }
  const float sc = P.in[I_PSCALE][l * 256 + gi * 64 + lane];
#pragma unroll
  for (int i = 0; i < 16; i++) P.mix[(size_t)(R0 + w * 16 + i) * DM + 256 + gi * 64 + lane] = f2bf(acc[i] * sc);
  __syncthreads();
}

DEV float xs_val(const Params& P, int l, int R, int col) {
  float pd = P.proj[(size_t)R * PRJ + 1536 + col];
  float prev;
  if (R >= TP) prev = P.in[I_SSHIFT][(size_t)(l * 128 + (R - TP)) * 896 + col];
  else prev = ((R & 2047) > 0) ? P.proj[(size_t)(R - 1) * PRJ + 1536 + col] : 0.f;
  return pd + (prev - pd) * P.in[I_MUD][l * 896 + col];
}

DEV void mixer_Dprep_item(const Params& P, int l, int st, char* smem) {
  float* sl = (float*)smem;
  const int tid = tidx(), lane = tid & 63, h = tid >> 6;
  const int R0 = st * 16;
#pragma unroll
  for (int idx = tid; idx < 2048; idx += 256) {
    int tt = idx >> 7, j = idx & 127;
    float x = xs_val(P, l, R0 + tt, 768 + j);
    float a = (j < 32) ? ftanh(x) : ((j < 64) ? x : sigm(x));
    sl[idx] = a;
  }
  __syncthreads();
  const int cn = h * 64 + lane;
  float accw[16], acca[16], accg[16];
#pragma unroll
  for (int i = 0; i < 16; i++) { accw[i] = 0.f; acca[i] = 0.f; accg[i] = 0.f; }
  const float* w2p = P.in[I_W2] + (size_t)l * 32 * 256 + cn;
  const float* a2p = P.in[I_A2] + (size_t)l * 32 * 256 + cn;
  const float* g2p = P.in[I_G2] + (size_t)l * 64 * 256 + cn;
#pragma unroll 2
  for (int j0 = 0; j0 < 32; j0 += 4) {
    float wv0 = w2p[(j0 + 0) * 256], wv1 = w2p[(j0 + 1) * 256], wv2 = w2p[(j0 + 2) * 256], wv3 = w2p[(j0 + 3) * 256];
    float av0 = a2p[(j0 + 0) * 256], av1 = a2p[(j0 + 1) * 256], av2 = a2p[(j0 + 2) * 256], av3 = a2p[(j0 + 3) * 256];
#pragma unroll
    for (int tt = 0; tt < 16; tt++) {
      float4 tw = *(const float4*)(sl + tt * 128 + j0);
      float4 ta = *(const float4*)(sl + tt * 128 + 32 + j0);
      accw[tt] = fmaf(tw.x, wv0, fmaf(tw.y, wv1, fmaf(tw.z, wv2, fmaf(tw.w, wv3, accw[tt]))));
      acca[tt] = fmaf(ta.x, av0, fmaf(ta.y, av1, fmaf(ta.z, av2, fmaf(ta.w, av3, acca[tt]))));
    }
  }
#pragma unroll 4
  for (int j0 = 0; j0 < 64; j0 += 4) {
    float gv0 = g2p[(j0 + 0) * 256], gv1 = g2p[(j0 + 1) * 256], gv2 = g2p[(j0 + 2) * 256], gv3 = g2p[(j0 + 3) * 256];
#pragma unroll
    for (int tt = 0; tt < 16; tt++) {
      float4 tg = *(const float4*)(sl + tt * 128 + 64 + j0);
      accg[tt] = fmaf(tg.x, gv0, fmaf(tg.y, gv1, fmaf(tg.z, gv2, fmaf(tg.w, gv3, accg[tt]))));
    }
  }
  const float w0 = P.in[I_W0][l * 256 + cn], a0 = P.in[I_A0][l * 256 + cn];
  const float kkw = P.in[I_KK][l * 256 + cn], kaw = P.in[I_KA][l * 256 + cn];
  float rr_[16], kk_[16], vv_[16];
#pragma unroll
  for (int tt = 0; tt < 16; tt++) {
    rr_[tt] = xs_val(P, l, R0 + tt, cn);
    kk_[tt] = xs_val(P, l, R0 + tt, 256 + cn);
    vv_[tt] = xs_val(P, l, R0 + tt, 512 + cn);
  }
#pragma unroll
  for (int tt = 0; tt < 16; tt++) {
    const int R = R0 + tt;
    float r = rr_[tt], k = kk_[tt], v = vv_[tt];
    float lw = w0 + accw[tt];
    float wlog = -softplus(-lw) - 0.5f;
    float decay = __expf(-__expf(wlog));
    float a = sigm(a0 + acca[tt]);
    float kk = k * kkw;
    float nrm = wave_sum(kk * kk);
    kk *= rsqrtf(fmaxf(nrm, 1e-12f));
    float k2 = k * (1.f + (a - 1.f) * kaw);
    float* o = P.scanin + ((size_t)R * 4 + h) * 384 + lane;
    o[0] = decay; o[64] = k2; o[128] = kk * a; o[192] = -kk; o[256] = r; o[320] = v;
    P.gbuf[(size_t)R * 256 + cn] = accg[tt];
  }
  __syncthreads();
}


DEV void phase_dprep(const Params& P, int l, char* smem) {
  float* sl = (float*)smem;
  constexpr int TK = 17;
  const int tid = tidx(), lane = tid & 63, h = tid >> 6;
  const int cn = h * 64 + lane;
  float w2v[32], a2v[32], g2v[64];
  {
    const float* w2p = P.in[I_W2] + (size_t)l * 32 * 256 + cn;
    const float* a2p = P.in[I_A2] + (size_t)l * 32 * 256 + cn;
    const float* g2p = P.in[I_G2] + (size_t)l * 64 * 256 + cn;
#pragma unroll
    for (int j = 0; j < 32; j++) { w2v[j] = w2p[j * 256]; a2v[j] = a2p[j * 256]; }
#pragma unroll
    for (int j = 0; j < 64; j++) g2v[j] = g2p[j * 256];
  }
  const float w0 = P.in[I_W0][l * 256 + cn], a0 = P.in[I_A0][l * 256 + cn];
  const float kkw = P.in[I_KK][l * 256 + cn], kaw = P.in[I_KA][l * 256 + cn];
  for (int item = blockIdx.x; item < (TT + TK - 1) / TK; item += gridDim.x) {
    const int R0 = item * TK;
    const int ntok = min(TK, TT - R0);
    __syncthreads();
#pragma unroll 2
    for (int idx = tid; idx < ntok * 128; idx += 256) {
      int tt = idx >> 7, j = idx & 127;
      float x = xs_val(P, l, R0 + tt, 768 + j);
      float a = (j < 32) ? ftanh(x) : ((j < 64) ? x : sigm(x));
      sl[idx] = a;
    }
    __syncthreads();
    float rN = xs_val(P, l, R0, cn), kN = xs_val(P, l, R0, 256 + cn), vN = xs_val(P, l, R0, 512 + cn);
#pragma unroll 1
    for (int tt = 0; tt < ntok; tt++) {
      const int R = R0 + tt;
      const float r = rN, k = kN, v = vN;
      {
        const int Rn = R0 + ((tt + 1 < ntok) ? tt + 1 : 0);
        rN = xs_val(P, l, Rn, cn); kN = xs_val(P, l, Rn, 256 + cn); vN = xs_val(P, l, Rn, 512 + cn);
      }
      float accw = 0.f, acca = 0.f, accg = 0.f;
      const float* sr = sl + tt * 128;
#pragma unroll
      for (int j0 = 0; j0 < 32; j0 += 4) {
        float4 tw = *(const float4*)(sr + j0);
        float4 ta = *(const float4*)(sr + 32 + j0);
        accw = fmaf(tw.x, w2v[j0], fmaf(tw.y, w2v[j0 + 1], fmaf(tw.z, w2v[j0 + 2], fmaf(tw.w, w2v[j0 + 3], accw))));
        acca = fmaf(ta.x, a2v[j0], fmaf(ta.y, a2v[j0 + 1], fmaf(ta.z, a2v[j0 + 2], fmaf(ta.w, a2v[j0 + 3], acca))));
      }
#pragma unroll
      for (int j0 = 0; j0 < 64; j0 += 4) {
        float4 tg = *(const float4*)(sr + 64 + j0);
        accg = fmaf(tg.x, g2v[j0], fmaf(tg.y, g2v[j0 + 1], fmaf(tg.z, g2v[j0 + 2], fmaf(tg.w, g2v[j0 + 3], accg))));
      }
      float lw = w0 + accw;
      float wlog = -softplus(-lw) - 0.5f;
      float decay = __expf(-__expf(wlog));
      float a = sigm(a0 + acca);
      float kk = k * kkw;
      float nrm = wave_sum(kk * kk);
      kk *= rsqrtf(fmaxf(nrm, 1e-12f));
      float k2 = k * (1.f + (a - 1.f) * kaw);
      float* o = P.scanin + ((size_t)R * 4 + h) * 384 + lane;
      o[0] = decay; o[64] = k2; o[128] = kk * a; o[192] = -kk; o[256] = r; o[320] = v;
      P.gbuf[(size_t)R * 256 + cn] = accg;
    }
  }
  __syncthreads();
}

DEV void phase_pool(const Params& P, int l, char* smem, int bid, int nb) {
  float* xs = (float*)smem;
  float* sd = (float*)(smem + 20480);
  const int tid = tidx(), lane = tid & 63, w = tid >> 6;
  const int gi = bid & 3;
  const int win = 2 << gi;
  const float rwin = 1.f / (float)win;
  float wv[64];
  {
    const float* wp = P.in[I_WPOOL] + (size_t)(l * 4 + gi) * 4096 + lane;
#pragma unroll
    for (int c = 0; c < 64; c++) wv[c] = wp[c * 64];
  }
  const float sc = P.in[I_PSCALE][l * 256 + gi * 64 + lane];
  const int nsub = TT / 64;
  for (int sub = (bid >> 2); sub < nsub; sub += (nb >> 2)) {
    const int R0 = sub * 64;
    __syncthreads();
    if (R0 < TP) {
      const int b = R0 >> 11, t0 = R0 & 2047;
#pragma unroll
      for (int i = 0; i < 5; i++) {
        int idx = tid + i * 256;
        if (idx < 79 * 16) {
          int rr = idx >> 4, c4 = (idx & 15) * 4;
          int t = t0 - 15 + rr;
          float4 v = make_float4(0.f, 0.f, 0.f, 0.f);
          if (t >= 0) v = *(const float4*)(P.proj + (size_t)(b * 2048 + t) * PRJ + 512 + gi * 64 + c4);
          *(float4*)(xs + rr * 64 + c4) = v;
        }
      }
      __syncthreads();
      {
        const int cc = lane, tb = w * 16;
        float s = 0.f;
#pragma unroll 1
        for (int j = 1; j < win; j++) s += xs[(tb + 15 - j) * 64 + cc];
#pragma unroll 2
        for (int i = 0; i < 16; i++) {
          const int tt = tb + i;
          const float xn = xs[(tt + 15) * 64 + cc];
          s += xn;
          const int pos = t0 + tt;
          const float rc = (pos + 1 >= win) ? rwin : frcp((float)(pos + 1));
          sd[tt * 64 + cc] = s * rc - xn;
          s -= xs[(tt + 16 - win) * 64 + cc];
        }
      }
    } else {
      const int sb0 = R0 - TP;
#pragma unroll 1
      for (int idx = tid; idx < 4096; idx += 256) {
        int tt = idx >> 6, cc = idx & 63;
        int sb = sb0 + tt;
        float x = P.proj[(size_t)(TP + sb) * PRJ + 512 + gi * 64 + cc];
        float s = x;
        const float* st = P.in[I_SPOOL] + (size_t)(l * 128 + sb) * 15 * 256 + gi * 64 + cc;
#pragma unroll 1
        for (int q = 16 - win; q < 15; q++) s += st[q * 256];
        sd[tt * 64 + cc] = s * rwin - x;
      }
    }
    __syncthreads();
#pragma unroll 1
    for (int i = 0; i < 16; i++) {
      const float* dr = sd + (w * 16 + i) * 64;
      float acc = 0.f;
#pragma unroll
      for (int c0 = 0; c0 < 64; c0 += 4) {
        float4 dd = *(const float4*)(dr + c0);
        acc = fmaf(dd.x, wv[c0], fmaf(dd.y, wv[c0 + 1], fmaf(dd.z, wv[c0 + 2], fmaf(dd.w, wv[c0 + 3], acc))));
      }
      P.mix[(size_t)(R0 + w * 16 + i) * DM + 256 + gi * 64 + lane] = f2bf(acc * sc);
    }
  }
  __syncthreads();
}

DEV float conv_z(const Params& P, int R, int c) {
  return P.proj[(size_t)R * PRJ + 1024 + c] * P.proj[(size_t)R * PRJ + 1280 + c];
}

DEV void phase_mixer_rest(const Params& P, int l, char* smem, int bid, int nb) {
  const int tid = tidx(), lane = tid & 63, w = tid >> 6;
#ifndef MIXREP
#define MIXREP 0
#endif
  for (int rep = 0; rep < 1 + (MIXREP & 1); rep++)
  for (int ia = 0; ia < (512 + nb - 1) / nb; ia++) {
    int it = bid + ia * nb;
    if (nb == 384 && ia == 1) it = (bid >= 256) ? 128 + bid : 512;
    if (it < 512) mixer_A_item(P, l, it >> 2, it & 3, smem);
  }
  for (int rep = 0; rep < 1 + ((MIXREP >> 2) & 1); rep++) phase_pool(P, l, smem, bid, nb);
  for (int sb = bid * 4 + w; sb < TS; sb += nb * 4) {
    const int R = TP + sb;
    float4 vn = ln_v_row(P, l, R, lane);
    *(float4*)(P.out + O_CVS + (size_t)(l * 128 + sb) * 256 + lane * 4) = vn;
    const int h = lane >> 4;
    float ws00 = P.in[I_WSC][(size_t)(l * 4 + h) * 16384];
    float bs0 = P.in[I_BCH][(l * 4 + h) * 128];
    float4 u = *(const float4*)(P.proj + (size_t)R * PRJ + lane * 4);
    uint2 pk;
    pk.x = pack2(u.x * (ws00 * vn.x + bs0), u.y * (ws00 * vn.y + bs0));
    pk.y = pack2(u.z * (ws00 * vn.z + bs0), u.w * (ws00 * vn.w + bs0));
    *(uint2*)(P.mix + (size_t)R * DM + lane * 4) = pk;
  }
  const int gt = bid * 256 + tid, gs = nb * 256;
  {
    const int ng = TT * 64;
    for (int g0 = gt; g0 < ng; g0 += 2 * gs) {
      float4 z0[2], z1[2], z2[2], bg[2];
      int Rr[2], cc[2];
      bool ok[2];
#pragma unroll
      for (int u = 0; u < 2; u++) {
        int g = g0 + u * gs;
        ok[u] = g < ng;
        if (!ok[u]) g = g0;
        int R = g >> 6, c = (g & 63) * 4;
        Rr[u] = R; cc[u] = c;
        const float* pr = P.proj + (size_t)R * PRJ;
        float4 a = *(const float4*)(pr + 1024 + c), b = *(const float4*)(pr + 1280 + c);
        z0[u] = make_float4(a.x * b.x, a.y * b.y, a.z * b.z, a.w * b.w);
        bg[u] = *(const float4*)(pr + 768 + c);
        if (R >= TP) {
          const float* sc = P.in[I_SCONV] + (size_t)(l * 128 + (R - TP)) * 512 + c;
          z2[u] = *(const float4*)(sc);
          z1[u] = *(const float4*)(sc + 256);
        } else {
          int t = R & 2047;
          z1[u] = make_float4(0.f, 0.f, 0.f, 0.f);
          z2[u] = make_float4(0.f, 0.f, 0.f, 0.f);
          if (t >= 1) {
            float4 a1 = *(const float4*)(pr - PRJ + 1024 + c), b1 = *(const float4*)(pr - PRJ + 1280 + c);
            z1[u] = make_float4(a1.x * b1.x, a1.y * b1.y, a1.z * b1.z, a1.w * b1.w);
          }
          if (t >= 2) {
            float4 a2 = *(const float4*)(pr - 2 * PRJ + 1024 + c), b2 = *(const float4*)(pr - 2 * PRJ + 1280 + c);
            z2[u] = make_float4(a2.x * b2.x, a2.y * b2.y, a2.z * b2.z, a2.w * b2.w);
          }
        }
      }
#pragma unroll
      for (int u = 0; u < 2; u++) {
        if (!ok[u]) continue;
        const float* cw = P.in[I_CONVW] + l * 768 + cc[u];
        float4 w0 = *(const float4*)(cw), w1 = *(const float4*)(cw + 256), w2 = *(const float4*)(cw + 512);
        float y0 = bg[u].x * (w0.x * z2[u].x + w1.x * z1[u].x + w2.x * z0[u].x);
        float y1 = bg[u].y * (w0.y * z2[u].y + w1.y * z1[u].y + w2.y * z0[u].y);
        float y2 = bg[u].z * (w0.z * z2[u].z + w1.z * z1[u].z + w2.z * z0[u].z);
        float y3 = bg[u].w * (w0.w * z2[u].w + w1.w * z1[u].w + w2.w * z0[u].w);
        *(uint2*)(P.mix + (size_t)Rr[u] * DM + 512 + cc[u]) = make_uint2(pack2(y0, y1), pack2(y2, y3));
      }
    }
  }
  for (int idx = gt; idx < 8 * 15 * 256; idx += gs) {
    int c = idx & 255, j = (idx >> 8) % 15, b = idx / (15 * 256);
    P.out[O_PLP + (size_t)l * 8 * 15 * 256 + idx] = P.proj[(size_t)(b * 2048 + 2033 + j) * PRJ + 512 + c];
  }
  for (int idx = gt; idx < 128 * 15 * 256; idx += gs) {
    int c = idx & 255, j = (idx >> 8) % 15, sb = idx / (15 * 256);
    float v = (j < 14) ? P.in[I_SPOOL][(size_t)(l * 128 + sb) * 15 * 256 + (j + 1) * 256 + c] : P.proj[(size_t)(TP + sb) * PRJ + 512 + c];
    P.out[O_PLS + (size_t)l * 128 * 15 * 256 + idx] = v;
  }
  for (int idx = gt; idx < 8 * 2 * 256; idx += gs) {
    int c = idx & 255, j = (idx >> 8) & 1, b = idx >> 9;
    P.out[O_CNP + (size_t)l * 8 * 512 + idx] = conv_z(P, b * 2048 + 2046 + j, c);
  }
  for (int idx = gt; idx < 128 * 2 * 256; idx += gs) {
    int c = idx & 255, j = (idx >> 8) & 1, sb = idx >> 9;
    float v = (j == 0) ? P.in[I_SCONV][(size_t)(l * 128 + sb) * 512 + 256 + c] : conv_z(P, TP + sb, c);
    P.out[O_CNS + (size_t)l * 128 * 512 + idx] = v;
  }
  for (int idx = gt; idx < 8 * 896; idx += gs) {
    int c = idx % 896, b = idx / 896;
    P.out[O_SHP + (size_t)l * 8 * 896 + idx] = P.proj[(size_t)(b * 2048 + 2047) * PRJ + 1536 + c];
  }
  for (int idx = gt; idx < 128 * 896; idx += gs) {
    int c = idx % 896, sb = idx / 896;
    P.out[O_SHS + (size_t)l * 128 * 896 + idx] = P.proj[(size_t)(TP + sb) * PRJ + 1536 + c];
  }
}

typedef __attribute__((ext_vector_type(2))) float f32x2;
struct WkvState { f32x2 a, b; };
DEV float wkv_step(WkvState& s, f32x4 w, f32x4 k, f32x4 ka, f32x4 nk, f32x4 r, float v) {
  f32x2 t = s.a * nk.xy;
  t = __builtin_elementwise_fma(s.b, nk.zw, t);
  float p = row16_sum(t.x + t.y);
  f32x2 p2 = (f32x2){p, p}, v2 = (f32x2){v, v};
  s.a = __builtin_elementwise_fma(s.a, w.xy, __builtin_elementwise_fma(p2, ka.xy, v2 * k.xy));
  s.b = __builtin_elementwise_fma(s.b, w.zw, __builtin_elementwise_fma(p2, ka.zw, v2 * k.zw));
  f32x2 q = s.a * r.xy;
  q = __builtin_elementwise_fma(s.b, r.zw, q);
  return row16_sum(q.x + q.y);
}

DEV void phase_scan(const Params& P, int l, char* smem, int cu_slot, int p_first, int p_stride, int s_first, int s_stride) {
  const int tid = tidx(), lane = tid & 63, w = tid >> 6;
  const int kq = lane & 15, rl = lane >> 4;
  unsigned* jc = P.bar + XB_JOBCTR(l);
  volatile unsigned* jobw = (volatile unsigned*)(smem + 49152 + 2048);
  (void)jc; (void)jobw; (void)cu_slot;
  {
  const bool do_sample = true;
  if (p_stride > 0)
  for (int job = p_first; job < 128; job += p_stride) {
    const int b = job >> 4, h = (job >> 2) & 3, rg = job & 3;
    const int row = rg * 16 + w * 4 + rl;
    f32x4* buf0 = (f32x4*)smem;
    f32x4* buf1 = (f32x4*)(smem + 24576);
    const float* src = P.scanin + ((size_t)(b * 2048) * 4 + h) * 384;
    f32x4 rgA[6], rgB[6];
#define SCAN_ISSUE(RG, c)                                                                  \
  {                                                                                        \
    const int cc_ = min((c), 127);                                                         \
    _Pragma("unroll") for (int i = 0; i < 6; i++) {                                        \
      int idx = tid + i * 256;                                                             \
      int stp = idx / 96, off = idx - stp * 96;                                            \
      RG[i] = *(const f32x4*)(src + (size_t)(cc_ * 16 + stp) * 1536 + off * 4);            \
    }                                                                                      \
  }
#define SCAN_CHUNK(c, CUR, NXT, RG)                                                        \
  {                                                                                        \
    __syncthreads();                                                                       \
    _Pragma("unroll") for (int i = 0; i < 6; i++) NXT[tid + i * 256] = RG[i];              \
    SCAN_ISSUE(RG, (c) + 3)                                                                \
    const float* cb = (const float*)CUR + kq * 4;                                          \
    const float* vb = (const float*)CUR + 320 + row;                                       \
    float* so = (float*)(smem + 49152) + ((c) & 1) * 256;                                  \
    {                                                                                      \
      const float* sp_ = (const float*)(smem + 49152) + (((c) + 1) & 1) * 256;             \
      const int cm_ = max((c) - 1, 0);                                                     \
      P.obuf[(size_t)(b * 2048 + cm_ * 16 + (tid >> 4)) * 256 + h * 64 + rg * 16 + (tid & 15)] = sp_[tid]; \
    }                                                                                      \
    f32x4 w4 = *(const f32x4*)(cb), k4 = *(const f32x4*)(cb + 64), a4 = *(const f32x4*)(cb + 128); \
    f32x4 n4 = *(const f32x4*)(cb + 192), r4 = *(const f32x4*)(cb + 256);                  \
    float v = vb[0];                                                                       \
    _Pragma("unroll 4") for (int st = 0; st < 16; st++) {                                  \
      const int sn = ((st + 1) & 15) * 384;                                                \
      f32x4 w4n = *(const f32x4*)(cb + sn), k4n = *(const f32x4*)(cb + sn + 64), a4n = *(const f32x4*)(cb + sn + 128); \
      f32x4 n4n = *(const f32x4*)(cb + sn + 192), r4n = *(const f32x4*)(cb + sn + 256);    \
      float vn = vb[sn];                                                                   \
      float o = wkv_step(s, w4, k4, a4, n4, r4, v);                                        \
      so[st * 16 + w * 4 + rl] = o;                                                        \
      asm volatile("" : "+v"(w4n), "+v"(k4n), "+v"(a4n), "+v"(n4n), "+v"(r4n), "+v"(vn));  \
      w4 = w4n; k4 = k4n; a4 = a4n; n4 = n4n; r4 = r4n; v = vn;                            \
    }                                                                                      \
  }
    __syncthreads();
    SCAN_ISSUE(rgA, 0)
#pragma unroll
    for (int i = 0; i < 6; i++) buf0[tid + i * 256] = rgA[i];
    SCAN_ISSUE(rgA, 1)
    SCAN_ISSUE(rgB, 2)
    WkvState s; s.a = (f32x2){0.f, 0.f}; s.b = (f32x2){0.f, 0.f};
    for (int c = 0; c < 128; c += 2) {
      SCAN_CHUNK(c, buf0, buf1, rgA)
      SCAN_CHUNK(c + 1, buf1, buf0, rgB)
    }
    __syncthreads();
    P.obuf[(size_t)(b * 2048 + 127 * 16 + (tid >> 4)) * 256 + h * 64 + rg * 16 + (tid & 15)] = ((const float*)(smem + 49152))[256 + tid];
    *(float4*)(P.out + O_WKP + ((size_t)((l * 8 + b) * 4 + h) * 64 + row) * 64 + kq * 4) = make_float4(s.a.x, s.a.y, s.b.x, s.b.y);
    __syncthreads();
  }
  if (do_sample)
  if (s_stride > 0)
  for (int sj = s_first; sj < 2048; sj += s_stride) {
    const int wj = sj * 4 + w;
    const int sb = wj >> 6, h = (wj >> 4) & 3, rg = wj & 15;
    const int row = rg * 4 + rl;
    const int R = TP + sb;
    const float* sp = P.scanin + ((size_t)R * 4 + h) * 384;
    f32x4 w4 = *(const f32x4*)(sp + kq * 4);
    f32x4 k4 = *(const f32x4*)(sp + 64 + kq * 4);
    f32x4 a4 = *(const f32x4*)(sp + 128 + kq * 4);
    f32x4 n4 = *(const f32x4*)(sp + 192 + kq * 4);
    f32x4 r4 = *(const f32x4*)(sp + 256 + kq * 4);
    float v = sp[320 + row];
    const size_t so = ((size_t)((l * 128 + sb) * 4 + h) * 64 + row) * 64 + kq * 4;
    float4 s0 = *(const float4*)(P.in[I_SWKV] + so);
    WkvState s; s.a = (f32x2){s0.x, s0.y}; s.b = (f32x2){s0.z, s0.w};
    float o = wkv_step(s, w4, k4, a4, n4, r4, v);
    if (kq == 0) P.obuf[(size_t)R * 256 + h * 64 + row] = o;
    *(float4*)(P.out + O_WKS + so) = make_float4(s.a.x, s.a.y, s.b.x, s.b.y);
  }
  }
}

DEV void phase_dpost(const Params& P, int l) {
  const int lane = tidx() & 63;
  const int gw = blockIdx.x * 4 + (tidx() >> 6), nw = gridDim.x * 4;
  for (int it0 = gw; it0 < TT * 4; it0 += 4 * nw) {
    float o[4], k2[4], r[4], v[4], g[4];
    int Rr[4], cnn[4];
    bool ok[4];
#pragma unroll
    for (int u = 0; u < 4; u++) {
      int it = it0 + u * nw;
      ok[u] = it < TT * 4;
      if (!ok[u]) it = it0;
      const int R = it >> 2, h = it & 3;
      const int cn = h * 64 + lane;
      Rr[u] = R; cnn[u] = cn;
      o[u] = P.obuf[(size_t)R * 256 + cn];
      const float* sp = P.scanin + ((size_t)R * 4 + h) * 384 + lane;
      k2[u] = sp[64]; r[u] = sp[256]; v[u] = sp[320];
      g[u] = P.gbuf[(size_t)R * 256 + cn];
    }
#pragma unroll
    for (int u = 0; u < 4; u++) {
      const int cn = cnn[u];
      float mu = wave_sum(o[u]) * (1.f / 64.f);
      float d = o[u] - mu;
      float var = wave_sum(d * d) * (1.f / 64.f);
      float on = d * rsqrtf(var + 64e-5f) * P.in[I_LNXG][l * 256 + cn] + P.in[I_LNXB][l * 256 + cn];
      float bon = wave_sum(r[u] * k2[u] * P.in[I_RK][l * 256 + cn]) * v[u];
      float y = (on + bon) * g[u];
      if (ok[u]) P.mix[(size_t)Rr[u] * DM + 768 + cn] = f2bf(y);
    }
  }
}

DEV void phase_ln(const Params& P, const float* g, const float* bta, float* dstf) {
  const int lane = tidx() & 63;
  const int gw = blockIdx.x * 4 + (tidx() >> 6), nw = gridDim.x * 4;
  for (int R0 = gw; R0 < TT; R0 += 2 * nw) {
    float4 x[2][4];
    int Rr[2];
    bool ok[2];
#pragma unroll
    for (int u = 0; u < 2; u++) {
      int R = R0 + u * nw;
      ok[u] = R < TT;
      if (!ok[u]) R = R0;
      Rr[u] = R;
      const float* src = P.pre + (size_t)R * DM;
#pragma unroll
      for (int i = 0; i < 4; i++) x[u][i] = *(const float4*)(src + i * 256 + lane * 4);
    }
#pragma unroll
    for (int u = 0; u < 2; u++) {
      float s = 0.f;
#pragma unroll
      for (int i = 0; i < 4; i++) s += x[u][i].x + x[u][i].y + x[u][i].z + x[u][i].w;
      float mu = wave_sum(s) * (1.f / 1024.f);
      float vs = 0.f;
#pragma unroll
      for (int i = 0; i < 4; i++) {
        x[u][i].x -= mu; x[u][i].y -= mu; x[u][i].z -= mu; x[u][i].w -= mu;
        vs += x[u][i].x * x[u][i].x + x[u][i].y * x[u][i].y + x[u][i].z * x[u][i].z + x[u][i].w * x[u][i].w;
      }
      float rs = rsqrtf(wave_sum(vs) * (1.f / 1024.f) + 1e-5f);
      if (ok[u]) {
#pragma unroll
        for (int i = 0; i < 4; i++) {
          int c = i * 256 + lane * 4;
          float4 gg = *(const float4*)(g + c), bb = *(const float4*)(bta + c);
          float4 y = make_float4(x[u][i].x * rs * gg.x + bb.x, x[u][i].y * rs * gg.y + bb.y, x[u][i].z * rs * gg.z + bb.z, x[u][i].w * rs * gg.w + bb.w);
          *(float4*)(dstf + (size_t)Rr[u] * DM + c) = y;
          *(uint2*)(P.xb + (size_t)Rr[u] * DM + c) = make_uint2(pack2(y.x, y.y), pack2(y.z, y.w));
        }
      }
    }
  }
}

DEV void attn_prompt_item(const Params& P, int l, int b, int h, int qt, char* smem) {
  u16* sQ = (u16*)smem;
  u16* sK = (u16*)(smem + 8192);
  const int tid = tidx(), lane = tid & 63, wave = tid >> 6;
  const int fr = lane & 15, fq = lane >> 4;
  const int lr = tid >> 3, ls = tid & 7;
  const int R0 = b * 2048 + qt * 64;
  const u16* kbp = P.kb + ((size_t)l * 2048 + b * 256) * 1024 + h * 256;
  const u16* vtp = P.vtb + ((size_t)(l * 8 + b) * 1024 + h * 256) * 256;
  f32x4 st[16];
#pragma unroll
  for (int i = 0; i < 16; i++) st[i] = (f32x4){0.f, 0.f, 0.f, 0.f};
  u32x4 pf[10];
  const u16* qsrc = P.qb + (size_t)(R0 + lr) * DM + h * 256 + ls * 8;
  const u16* ksrc = kbp + (size_t)lr * 1024 + ls * 8;
  const u16* vsrc = vtp + (size_t)lr * 256 + ls * 8;
  const int loff = lr * 64 + ((ls ^ (lr & 7)) * 8);
#pragma unroll
  for (int i = 0; i < 8; i++) pf[i] = *(const u32x4*)(ksrc + (size_t)(i * 32) * 1024);
#pragma unroll
  for (int i = 0; i < 2; i++) pf[8 + i] = *(const u32x4*)(qsrc + (size_t)(i * 32) * DM);
  for (int kc = 0; kc < 4; kc++) {
    __syncthreads();
#pragma unroll
    for (int i = 0; i < 8; i++) *(u32x4*)(sK + loff + i * 2048) = pf[i];
#pragma unroll
    for (int i = 0; i < 2; i++) *(u32x4*)(sQ + loff + i * 2048) = pf[8 + i];
    __syncthreads();
    if (kc < 3) {
#pragma unroll
      for (int i = 0; i < 8; i++) pf[i] = *(const u32x4*)(ksrc + (size_t)(i * 32) * 1024 + (kc + 1) * 64);
#pragma unroll
      for (int i = 0; i < 2; i++) pf[8 + i] = *(const u32x4*)(qsrc + (size_t)(i * 32) * DM + (kc + 1) * 64);
    } else {
#pragma unroll
      for (int i = 0; i < 8; i++) pf[i] = *(const u32x4*)(vsrc + (size_t)(i * 32) * 256);
    }
#pragma unroll
    for (int ks = 0; ks < 2; ks++) {
      const int slot = ks * 4 + fq;
      const int qrow = wave * 16 + fr;
      bf16x8 bq = *(const bf16x8*)(sQ + qrow * 64 + ((slot ^ (qrow & 7)) * 8));
#pragma unroll
      for (int mi = 0; mi < 16; mi++) {
        int krow = mi * 16 + fr;
        bf16x8 ak = *(const bf16x8*)(sK + krow * 64 + ((slot ^ (krow & 7)) * 8));
        st[mi] = __builtin_amdgcn_mfma_f32_16x16x32_bf16(ak, bq, st[mi], 0, 0, 0);
      }
    }
  }
  float mx = -3.0e38f;
#pragma unroll
  for (int mi = 0; mi < 16; mi++)
#pragma unroll
    for (int e = 0; e < 4; e++) mx = fmaxf(mx, st[mi][e]);
  mx = fmaxf(mx, __shfl_xor(mx, 16));
  mx = fmaxf(mx, __shfl_xor(mx, 32));
  float sum = 0.f;
#pragma unroll
  for (int mi = 0; mi < 16; mi++)
#pragma unroll
    for (int e = 0; e < 4; e++) {
      float p = __expf(st[mi][e] - mx);
      st[mi][e] = p;
      sum += p;
    }
  sum += __shfl_xor(sum, 16);
  sum += __shfl_xor(sum, 32);
  const float inv = 1.f / sum;
  unsigned pb[16][2];
#pragma unroll
  for (int mi = 0; mi < 16; mi++) {
    pb[mi][0] = pack2(st[mi][0] * inv, st[mi][1] * inv);
    pb[mi][1] = pack2(st[mi][2] * inv, st[mi][3] * inv);
  }
  f32x4 ot[16];
#pragma unroll
  for (int i = 0; i < 16; i++) ot[i] = (f32x4){0.f, 0.f, 0.f, 0.f};
  for (int mc = 0; mc < 4; mc++) {
    __syncthreads();
#pragma unroll
    for (int i = 0; i < 8; i++) *(u32x4*)(sK + loff + i * 2048) = pf[i];
    __syncthreads();
    {
      const int mn = min(mc + 1, 3);
#pragma unroll
      for (int i = 0; i < 8; i++) pf[i] = *(const u32x4*)(vsrc + (size_t)(i * 32) * 256 + mn * 64);
    }
#pragma unroll
    for (int kkl = 0; kkl < 2; kkl++) {
      unsigned p0 = 0, p1 = 0, p2 = 0, p3 = 0;
#pragma unroll
      for (int m2 = 0; m2 < 4; m2++) {
        if (m2 == mc) {
          p0 = pb[(m2 * 2 + kkl) * 2][0]; p1 = pb[(m2 * 2 + kkl) * 2][1];
          p2 = pb[(m2 * 2 + kkl) * 2 + 1][0]; p3 = pb[(m2 * 2 + kkl) * 2 + 1][1];
        }
      }
      union { unsigned u[4]; bf16x8 v; } bp;
      bp.u[0] = p0; bp.u[1] = p1; bp.u[2] = p2; bp.u[3] = p3;
#pragma unroll
      for (int dt = 0; dt < 16; dt++) {
        int d = dt * 16 + fr;
        const u16* rowp = sK + d * 64 + (fq & 1) * 4;
        uint2 lo = *(const uint2*)(rowp + (((kkl * 4 + (fq >> 1)) ^ (d & 7)) * 8));
        uint2 hi = *(const uint2*)(rowp + (((kkl * 4 + 2 + (fq >> 1)) ^ (d & 7)) * 8));
        union { unsigned u[4]; bf16x8 v; } av;
        av.u[0] = lo.x; av.u[1] = lo.y; av.u[2] = hi.x; av.u[3] = hi.y;
        ot[dt] = __builtin_amdgcn_mfma_f32_16x16x32_bf16(av.v, bp.v, ot[dt], 0, 0, 0);
      }
    }
  }
  u16* op = P.ao + (size_t)(R0 + wave * 16 + fr) * DM + h * 256 + fq * 4;
#pragma unroll
  for (int dt = 0; dt < 16; dt++) *(uint2*)(op + dt * 16) = make_uint2(pack2(ot[dt][0], ot[dt][1]), pack2(ot[dt][2], ot[dt][3]));
  __syncthreads();
}

DEV void attn_sample_item(const Params& P, int l, int sb, int h, char* smem) {
  float* sc = (float*)smem;
  float* so = (float*)(smem + 1024);
  const int tid = tidx(), lane = tid & 63, w = tid >> 6;
  const int R = TP + sb;
  const u16* qp = P.qb + (size_t)R * DM + h * 256 + lane * 4;
  uint2 qraw = *(const uint2*)qp;
  float q0 = bf2f((u16)(qraw.x & 0xffff)), q1 = bf2f((u16)(qraw.x >> 16)), q2 = bf2f((u16)(qraw.y & 0xffff)), q3 = bf2f((u16)(qraw.y >> 16));
  const float* kp = P.in[I_CK] + ((size_t)(l * 128 + sb) * 256) * 1024 + h * 256 + lane * 4;
  const float* vp = P.in[I_CV] + ((size_t)(l * 128 + sb) * 256) * 1024 + h * 256 + lane * 4;
  __syncthreads();
  for (int m0 = 0; m0 < 64; m0 += 8) {
    f32x4 kv[8];
#pragma unroll
    for (int j = 0; j < 8; j++) kv[j] = __builtin_nontemporal_load((const f32x4*)(kp + (size_t)(w * 64 + m0 + j) * 1024));
#pragma unroll
    for (int j = 0; j < 8; j++) {
      float d = wave_sum(kv[j][0] * q0 + kv[j][1] * q1 + kv[j][2] * q2 + kv[j][3] * q3);
      if (lane == 0) sc[w * 64 + m0 + j] = d;
    }
  }
  __syncthreads();
  float4 s4 = *(const float4*)(sc + lane * 4);
  float mx = fmaxf(fmaxf(s4.x, s4.y), fmaxf(s4.z, s4.w));
#pragma unroll
  for (int o = 1; o < 64; o <<= 1) mx = fmaxf(mx, __shfl_xor(mx, o));
  float sum = wave_sum(__expf(s4.x - mx) + __expf(s4.y - mx) + __expf(s4.z - mx) + __expf(s4.w - mx));
  const float inv = 1.f / sum;
  float4 acc = make_float4(0.f, 0.f, 0.f, 0.f);
  for (int m0 = 0; m0 < 64; m0 += 8) {
    f32x4 vv[8];
#pragma unroll
    for (int j = 0; j < 8; j++) vv[j] = __builtin_nontemporal_load((const f32x4*)(vp + (size_t)(w * 64 + m0 + j) * 1024));
#pragma unroll
    for (int j = 0; j < 8; j++) {
      float p = __expf(sc[w * 64 + m0 + j] - mx) * inv;
      acc.x = fmaf(p, vv[j][0], acc.x); acc.y = fmaf(p, vv[j][1], acc.y); acc.z = fmaf(p, vv[j][2], acc.z); acc.w = fmaf(p, vv[j][3], acc.w);
    }
  }
  *(float4*)(so + w * 256 + lane * 4) = acc;
  __syncthreads();
  {
    float o = so[tid] + so[256 + tid] + so[512 + tid] + so[768 + tid];
    P.ao[(size_t)R * DM + h * 256 + tid] = f2bf(o);
  }
  __syncthreads();
}

DEV void phase_attn(const Params& P, int l, char* smem) {
  const bool sfirst = ((1024 % gridDim.x) == 0) && ((blockIdx.x >> 3) & 1);
  for (int it0 = blockIdx.x; it0 < 1536; it0 += gridDim.x) {
    const int it = sfirst ? ((it0 + 1024) % 1536) : it0;
    if (it < 1024) attn_prompt_item(P, l, it >> 7, (it >> 5) & 3, it & 31, smem);
    else attn_sample_item(P, l, (it - 1024) >> 2, (it - 1024) & 3, smem);
  }
}

constexpr int N_PHASES = 27;
#ifndef PH_MASK
#define PH_MASK 0xffffu
#endif

DEV void run_stage(const Params& P, int l, int s, char* smem, int cu_slot) {
  if (s == 13) { if (PH_MASK & 0x2000u) phase_prep(P, smem); return; }
  if (!((PH_MASK >> s) & 1u)) return;
  switch (s) {
    case 0:
      if (!(PH_MASK & 1u)) break;
      gemm_phase(P, EP_PROJ, l, P.xb, DM, P.wt + l * W_LAYER + WO_IN, DM, DM, TT / 128, PRJ / 128, smem);
      if (l == 0) {
        const int nb = gridDim.x;
        if ((nb & 7) == 0) {
          const int x = blockIdx.x & 7, bl = blockIdx.x >> 3, per = nb >> 3;
          for (int v = per - 1 - bl; v < 64; v += per) {
            if (v < 0) continue;
            const int u = x * 64 + v;
            const int ll = u >> 8, kv = (u >> 7) & 1, t = u & 127;
            gemm_tile<4>(P, kv ? EP_MEMV : EP_MEMK, ll, P.memb, DM, P.wt + ll * W_LAYER + (kv ? WO_XV : WO_XK), DM, DM,
                         (t >> 3) * 128, (t & 7) * 128, smem);
          }
        } else {
          for (int u = blockIdx.x; u < 512; u += nb) {
            const int ll = u >> 8, kv = (u >> 7) & 1, t = u & 127;
            gemm_tile<4>(P, kv ? EP_MEMV : EP_MEMK, ll, P.memb, DM, P.wt + ll * W_LAYER + (kv ? WO_XV : WO_XK), DM, DM,
                         (t >> 3) * 128, (t & 7) * 128, smem);
          }
        }
      }
      break;
    case 1: if (!(PH_MASK & 2u)) break; phase_dprep(P, l, smem); break;
    case 2: {
      if (!(PH_MASK & 4u)) break;
      const int nb = gridDim.x, bid = blockIdx.x;
      if (nb >= 256 && ((nb - 128) & 3) == 0) {
        if (bid < 128) phase_scan(P, l, smem, cu_slot, bid, nb, 0, 0);
        else {
          phase_scan(P, l, smem, cu_slot, 0, 0, bid - 128, nb - 128);
          phase_mixer_rest(P, l, smem, bid - 128, nb - 128);
        }
      } else {
        phase_scan(P, l, smem, cu_slot, bid, nb, nb - 1 - bid, nb);
        phase_mixer_rest(P, l, smem, bid, nb);
      }
    } break;
    case 3: if (!(PH_MASK & 8u)) break; phase_dpost(P, l); break;
    case 4: if (!(PH_MASK & 16u)) break; gemm_phase(P, EP_RES, l, P.mix, DM, P.wt + l * W_LAYER + WO_OUT, DM, DM, TT / 128, 8, smem, 1); break;
    case 5: if (!(PH_MASK & 32u)) break; phase_ln(P, P.in[I_LN1G] + l * DM, P.in[I_LN1B] + l * DM, P.hf); break;
    case 6: if (!(PH_MASK & 64u)) break; gemm_phase(P, EP_Q, l, P.xb, DM, P.wt + l * W_LAYER + WO_XQ, DM, DM, TT / 128, 8, smem, 1); break;
    case 7: if (!(PH_MASK & 128u)) break; phase_attn(P, l, smem); break;
    case 8: if (!(PH_MASK & 256u)) break; gemm_phase(P, EP_RES, l, P.ao, DM, P.wt + l * W_LAYER + WO_XO, DM, DM, TT / 128, 8, smem, 1); break;
    case 9: if (!(PH_MASK & 512u)) break; phase_ln(P, P.in[I_LN2G] + l * DM, P.in[I_LN2B] + l * DM, P.hf); break;
    case 10: if (!(PH_MASK & 1024u)) break; gemm_phase(P, EP_FFN1, l, P.xb, DM, P.wt + l * W_LAYER + WO_13, DM, DM, TT / 128, (2 * DFF) / 128, smem); break;
    case 11: if (!(PH_MASK & 2048u)) break; gemm_phase(P, EP_RES, l, P.ffh, DFF, P.wt + l * W_LAYER + WO_2, DFF, DFF, TT / 128, 8, smem, 1); break;
    case 12: if (!(PH_MASK & 4096u)) break; phase_ln(P, P.in[I_LN3G] + l * DM, P.in[I_LN3B] + l * DM, (l == 1) ? P.out : P.hf); break;
  }
}


#define XB_TMO      128
#define XB_XCNT(j)  (256  + 64 * (j))
#define XB_XSUB(j)  (1280 + 64 * (j))
#define XB_XGEN(j)  (2304 + 64 * (j))
#define XB_TOP      3328
#define XB_TOPGEN   3392
#define XCD_BAR_WORDS 3456
#define XB_SPIN_CAP (1u << 23)
#define LAS __attribute__((address_space(3)))
DEV unsigned xb_ld(unsigned* p) { return __hip_atomic_load(p, __ATOMIC_RELAXED, __HIP_MEMORY_SCOPE_AGENT); }
DEV unsigned xb_add(unsigned* p, unsigned v) { return __hip_atomic_fetch_add(p, v, __ATOMIC_RELAXED, __HIP_MEMORY_SCOPE_AGENT); }
DEV unsigned xb_xcc_id() { return (unsigned)__builtin_amdgcn_s_getreg((3 << 11) | 20) & 0xFu; }
#define XB_SPIN(cond, bar) do { unsigned _sp = 0; while (cond) { __builtin_amdgcn_s_sleep(1); \
    if ((++_sp & 255u) == 0u) { if (xb_ld(&(bar)[XB_TMO])) break; if (_sp > XB_SPIN_CAP) { atomicAdd(&(bar)[XB_TMO], 1u); break; } } } } while (0)
struct XcdBarrier { unsigned* bar; unsigned x; volatile LAS unsigned* st; };
DEV XcdBarrier xcd_barrier_post(unsigned* bar, volatile LAS unsigned* st) {
  XcdBarrier b; b.bar = bar; b.x = xb_xcc_id(); b.st = st;
  if (threadIdx.x == 0) (void)xb_add(&bar[XB_XCNT(b.x)], 1u);
  return b;
}
DEV void xcd_barrier_complete(unsigned* bar, unsigned x, unsigned& nloc, unsigned& nx) {
  const unsigned G = gridDim.x * gridDim.y * gridDim.z;
  unsigned sum, cnt, mine, sp = 0u;
  for (;;) {
    sum = 0u; cnt = 0u; mine = 0u;
#pragma unroll
    for (unsigned j = 0; j < 16; ++j) { const unsigned c = xb_ld(&bar[XB_XCNT(j)]); sum += c; cnt += (c > 0u) ? 1u : 0u; mine = (j == x) ? c : mine; }
    if (sum == G) break;
    __builtin_amdgcn_s_sleep(1);
    if ((++sp & 255u) == 0u) { if (xb_ld(&bar[XB_TMO])) break; if (sp > XB_SPIN_CAP) { atomicAdd(&bar[XB_TMO], 1u); break; } }
  }
  nloc = mine > 0u ? mine : 1u; nx = cnt > 0u ? cnt : 1u;
}
DEV void xcd_barrier(const XcdBarrier& b) {
  asm volatile("s_waitcnt vmcnt(0)" ::: "memory");
  __syncthreads();
  if (threadIdx.x == 0) {
    unsigned* bar = b.bar;
    __builtin_amdgcn_s_waitcnt(0);
    unsigned nloc = b.st[0], nx = b.st[1];
    if (nloc == 0u) { xcd_barrier_complete(bar, b.x, nloc, nx); b.st[0] = nloc; b.st[1] = nx; }
    const unsigned old = xb_add(&bar[XB_XSUB(b.x)], 1u);
    const unsigned gen = old / nloc;
    if (old + 1u == (gen + 1u) * nloc) {
      __builtin_amdgcn_fence(__ATOMIC_RELEASE, "agent");
      asm volatile("s_waitcnt vmcnt(0)" ::: "memory");
      const unsigned og = xb_add(&bar[XB_TOP], 1u);
      const unsigned tg = og / nx;
      if (og + 1u == (tg + 1u) * nx) xb_add(&bar[XB_TOPGEN], 1u);
      else XB_SPIN(xb_ld(&bar[XB_TOPGEN]) == tg, bar);
      __builtin_amdgcn_fence(__ATOMIC_ACQUIRE, "agent");
      xb_add(&bar[XB_XGEN(b.x)], 1u);
      asm volatile("s_waitcnt vmcnt(0)" ::: "memory");
    } else {
      XB_SPIN(xb_ld(&bar[XB_XGEN(b.x)]) == gen, bar);
      __builtin_amdgcn_fence(__ATOMIC_ACQUIRE, "agent");
      asm volatile("s_waitcnt vmcnt(0)" ::: "memory");
    }
  }
  __syncthreads();
}

#ifndef REPEAT_MASK
#define REPEAT_MASK 0u
#endif
__global__ void __launch_bounds__(256, 2) mega_coop(Params P) {
  __shared__ __attribute__((aligned(16))) char smem[65536];
  __shared__ uint4 xb_words;
  if (threadIdx.x == 0) xb_words = make_uint4(0u, 0u, 0u, 0u);
  __syncthreads();
  XcdBarrier xb = xcd_barrier_post(P.bar, (volatile LAS unsigned*)&xb_words);
  __shared__ int cu_slot_s;
  if (threadIdx.x == 0) {
    const unsigned hw = (unsigned)__builtin_amdgcn_s_getreg((7 << 11) | (8 << 6) | 4);
    const unsigned key = ((xb.x & 15u) << 8) | (hw & 255u);
    cu_slot_s = (int)atomicAdd(&P.bar[XB_CUTAB + key], 1u);
  }
  __syncthreads();
  const int cu_slot = cu_slot_s;
  if (P.out == nullptr) cg::this_grid().sync();
  run_stage(P, 0, 13, smem, cu_slot);
  for (int ph = 0; ph < 26; ph++) {
    xcd_barrier(xb);
    run_stage(P, ph / 13, ph % 13, smem, cu_slot);
    if ((REPEAT_MASK >> (ph % 13)) & 1u) { xcd_barrier(xb); run_stage(P, ph / 13, ph % 13, smem, cu_slot); }
  }
}

__global__ void __launch_bounds__(256, 2) mega_range(Params P, int ph_lo, int ph_hi) {
  __shared__ __attribute__((aligned(16))) char smem[65536];
  const int cu_slot = blockIdx.x & 1;
  if (ph_lo < 0) { run_stage(P, 0, 13, smem, cu_slot); ph_lo = 0; }
  for (int ph = ph_lo; ph < ph_hi; ph++) {
    if (ph > ph_lo) __syncthreads();
    run_stage(P, ph / 13, ph % 13, smem, cu_slot);
  }
}

#ifndef USE_COOP
#define USE_COOP 1
#endif

extern "C" void kernel_launch(void* const* d_in, const int* in_sizes, int n_in, void* d_out, int out_size, void* d_ws, size_t ws_size,
                              hipStream_t stream) {
  Params P{};
  for (int i = 0; i < 42; i++) P.in[i] = (const float*)d_in[i];
  P.out = (float*)d_out;
  char* ws = (char*)d_ws;
  size_t off = 0;
  auto take = [&](size_t bytes) { char* p = ws + off; off += (bytes + 255) & ~(size_t)255; return p; };
  P.wt = (u16*)take((size_t)2 * W_LAYER * 2);
  P.xb = (u16*)take((size_t)TT * DM * 2);
  P.hf = (float*)take((size_t)TT * DM * 4);
  P.proj = (float*)take((size_t)TT * PRJ * 4);
  P.mix = (u16*)take((size_t)TT * DM * 2);
  P.pre = (float*)take((size_t)TT * DM * 4);
  P.qb = (u16*)take((size_t)TT * DM * 2);
  P.ao = (u16*)take((size_t)TT * DM * 2);
  P.ffh = (u16*)take((size_t)TT * DFF * 2);
  P.scanin = (float*)take((size_t)TT * 4 * 384 * 4);
  P.obuf = (float*)take((size_t)TT * 256 * 4);
  P.gbuf = (float*)take((size_t)TT * 256 * 4);
  P.memb = (u16*)take((size_t)2048 * DM * 2);
  P.kb = (u16*)take((size_t)2 * 2048 * DM * 2);
  P.vtb = (u16*)take((size_t)2 * 2048 * DM * 2);
  P.bar = (unsigned*)take((size_t)XB_TOTAL_WORDS * 4);
  if (off > ws_size) { fprintf(stderr, "workspace too small: need %zu have %zu\n", off, ws_size); return; }

  static int grid_blocks = 0;
  if (!grid_blocks) {
    int dev = 0, cus = 0, per_cu = 0;
    hipGetDevice(&dev);
    hipDeviceGetAttribute(&cus, hipDeviceAttributeMultiprocessorCount, dev);
    hipOccupancyMaxActiveBlocksPerMultiprocessor(&per_cu, mega_coop, 256, 0);
    if (per_cu > 2) per_cu = 2;
    if (per_cu < 1) per_cu = 1;
    grid_blocks = cus * per_cu;
  }
  (void)hipMemsetAsync(P.bar, 0, (size_t)XB_TOTAL_WORDS * 4, stream);
#if USE_COOP
  void* args[] = {&P};
  hipError_t e = hipLaunchCooperativeKernel((void*)mega_coop, dim3(grid_blocks), dim3(256), args, 0, stream);
  if (e != hipSuccess) fprintf(stderr, "cooperative launch failed: %s (grid %d)\n", hipGetErrorString(e), grid_blocks);
#else
  mega_range<<<grid_blocks, 256, 0, stream>>>(P, -1, 0);
  for (int ph = 0; ph < 26; ph++) mega_range<<<grid_blocks, 256, 0, stream>>>(P, ph, ph + 1);
#endif
}
```
